# Optimizing an MI355X kernel written in HIP

```python
import math
import jax, jax.numpy as jnp
from jax import lax
import numpy as np

D_MODEL = 1024
BATCH = 8
SEQ = 4096
DEPTH = 1

D_RNN = 1024
RNN_BLOCKS = 16
RNN_BLOCK = D_RNN // RNN_BLOCKS
CONV_W = 4
RGLRU_C = 8.0
N_HEADS = 8
HEAD_DIM = 64
V_DIM = 2 * HEAD_DIM
ATT_QK = N_HEADS * 2 * HEAD_DIM
ATT_V = N_HEADS * V_DIM
Q_BLOCK = 128
N_BRANCH = 2
D_IN = 2 * D_RNN + 2 * ATT_QK + ATT_V + N_BRANCH * D_MODEL
NUM_BUCKETS = 32
MAX_EXACT = NUM_BUCKETS // 2
MAX_DISTANCE = 128
N_EXPERTS = 32
TOP_K = 4
D_FF = D_MODEL
SWIGLU_LIMIT = 7.0
SWIGLU_ALPHA = 1.702
MOE_BLOCK = 128
EPS = 1e-6
NEG_INF = -1e30

kernel_name = 'hybrid_rglru_diffattn_moe_block'


def rms_norm(x, g):
    xf = x.astype(jnp.float32)
    y = xf * lax.rsqrt(jnp.mean(xf * xf, axis=-1, keepdims=True) + EPS)
    return (y * g.astype(jnp.float32)).astype(x.dtype)


def lambda_init(layer):
    return 0.8 - 0.6 * math.exp(-0.3 * layer)


def rel_bucket(q_pos, k_pos):
    n = jnp.maximum(q_pos[:, None] - k_pos[None, :], 0)
    nf = jnp.maximum(n, MAX_EXACT).astype(jnp.float32)
    large = MAX_EXACT + (jnp.log(nf / MAX_EXACT) / math.log(MAX_DISTANCE / MAX_EXACT) * (NUM_BUCKETS - MAX_EXACT)).astype(jnp.int32)
    large = jnp.minimum(large, NUM_BUCKETS - 1)
    return jnp.where(n < MAX_EXACT, n, large)


def _lru_combine(c1, c2):
    a1, b1 = c1
    a2, b2 = c2
    return a1 * a2, a2 * b1 + b2


def rglru_branch(xr, gate, conv_w, conv_b, w_a, b_a, w_x, b_x, lru_lambda):
    B, S, _ = xr.shape
    xc = lax.conv_general_dilated(xr, conv_w[:, None, :].astype(xr.dtype), window_strides=(1,), padding=[(CONV_W - 1, 0)], dimension_numbers=('NWC', 'WIO', 'NWC'), feature_group_count=D_RNN) + conv_b
    xb = xc.reshape(B, S, RNN_BLOCKS, RNN_BLOCK)
    r = jax.nn.sigmoid(jnp.einsum('bsnc,ncd->bsnd', xb, w_a) + b_a).reshape(B, S, D_RNN)
    i = jax.nn.sigmoid(jnp.einsum('bsnc,ncd->bsnd', xb, w_x) + b_x).reshape(B, S, D_RNN)
    log_a = -RGLRU_C * r.astype(jnp.float32) * jax.nn.softplus(-lru_lambda.astype(jnp.float32))
    a = jnp.exp(log_a)
    mult = jnp.sqrt(-jnp.expm1(2.0 * log_a))
    u = mult * (i * xc).astype(jnp.float32)
    _, h = lax.associative_scan(_lru_combine, (a, u), axis=1)
    return h.astype(xr.dtype) * jax.nn.gelu(gate, approximate=True)


def diff_attention(q, k, v, lam, lam_init, subln_g, rel_table):
    B, S = q.shape[0], q.shape[1]
    qt = q.transpose(3, 0, 2, 1, 4)
    kt = k.transpose(3, 0, 2, 1, 4)
    vt = v.transpose(0, 2, 1, 3)
    k_pos = jnp.arange(S, dtype=jnp.int32)
    scale = HEAD_DIM ** -0.5

    def block(blk):
        start = blk * Q_BLOCK
        qb = lax.dynamic_slice_in_dim(qt, start, Q_BLOCK, axis=3)
        q_pos = start + jnp.arange(Q_BLOCK, dtype=jnp.int32)
        bias = rel_table[rel_bucket(q_pos, k_pos)].transpose(2, 0, 1).astype(jnp.float32)
        mask = k_pos[None, :] <= q_pos[:, None]
        s = jnp.einsum('nbhqd,nbhkd->nbhqk', qb, kt).astype(jnp.float32) * scale + bias
        p = jax.nn.softmax(jnp.where(mask, s, NEG_INF), axis=-1)
        w = p[0] - lam * p[1]
        return jnp.einsum('bhqk,bhkd->bhqd', w.astype(v.dtype), vt)

    o = lax.map(block, jnp.arange(S // Q_BLOCK, dtype=jnp.int32))
    o = o.transpose(1, 0, 3, 2, 4).reshape(B, S, N_HEADS, V_DIM)
    o = rms_norm(o, subln_g) * (1.0 - lam_init)
    return o.reshape(B, S, ATT_V)


def moe_ffn(h, w_router, b_router, w_gate_e, b_gate_e, w_up_e, b_up_e, w_down_e, b_down_e):
    B, S, D = h.shape
    T = B * S
    TK = T * TOP_K
    xt = h.reshape(T, D)
    logits = (xt @ w_router + b_router).astype(jnp.float32)
    top_val, top_idx = lax.top_k(logits, TOP_K)
    weights = jax.nn.softmax(top_val, axis=-1)
    flat_e = top_idx.reshape(-1)
    flat_tok = jnp.arange(TK, dtype=jnp.int32) // TOP_K
    flat_w = weights.reshape(-1)
    order = jnp.argsort(flat_e)
    s_e, s_tok, s_w = flat_e[order], flat_tok[order], flat_w[order]
    counts = jnp.bincount(flat_e, length=N_EXPERTS)
    starts = jnp.cumsum(counts) - counts
    padded = (counts + MOE_BLOCK - 1) // MOE_BLOCK * MOE_BLOCK
    ends_p = jnp.cumsum(padded)
    starts_p = ends_p - padded
    dest = starts_p[s_e] + (jnp.arange(TK, dtype=jnp.int32) - starts[s_e])
    n_blocks = TK // MOE_BLOCK + N_EXPERTS
    P = n_blocks * MOE_BLOCK
    slot_tok = jnp.full((P,), T, dtype=jnp.int32).at[dest].set(s_tok)
    slot_w = jnp.zeros((P,), jnp.float32).at[dest].set(s_w)
    block_expert = jnp.minimum(jnp.searchsorted(ends_p, jnp.arange(n_blocks, dtype=jnp.int32) * MOE_BLOCK, side='right'), N_EXPERTS - 1)
    x_slots = xt.at[slot_tok].get(mode='fill', fill_value=0).reshape(n_blocks, MOE_BLOCK, D)

    def expert_block(args):
        xb, e = args
        g = xb @ w_gate_e[e] + b_gate_e[e]
        u = xb @ w_up_e[e] + b_up_e[e]
        g = jnp.minimum(g, SWIGLU_LIMIT)
        u = jnp.clip(u, -SWIGLU_LIMIT, SWIGLU_LIMIT)
        act = (u + 1.0) * (g * jax.nn.sigmoid(SWIGLU_ALPHA * g))
        return act @ w_down_e[e] + b_down_e[e]

    y_slots = lax.map(expert_block, (x_slots, block_expert)).reshape(P, D)
    y = jnp.zeros((T, D), h.dtype).at[slot_tok].add(slot_w[:, None].astype(h.dtype) * y_slots, mode='drop')
    return y.reshape(B, S, D)


def setup_inputs(seed: int = 0) -> dict:
    key = jax.random.key(seed)
    ks = jax.random.split(key, 32)
    L = DEPTH

    def nrm(k, shape, scale):
        return jax.random.normal(k, shape, jnp.float32) * scale

    a0 = jax.random.uniform(ks[9], (L, D_RNN), jnp.float32, 0.9, 0.999)
    return {
        'x': nrm(ks[0], (BATCH, SEQ, D_MODEL), 1.0),
        'norm_mix_g': 1.0 + nrm(ks[1], (L, D_MODEL), 0.05),
        'w_in': nrm(ks[2], (L, D_MODEL, D_IN), D_MODEL ** -0.5),
        'conv_w': nrm(ks[3], (L, CONV_W, D_RNN), CONV_W ** -0.5),
        'conv_b': nrm(ks[4], (L, D_RNN), 0.02),
        'w_rg_a': nrm(ks[5], (L, RNN_BLOCKS, RNN_BLOCK, RNN_BLOCK), RNN_BLOCK ** -0.5),
        'b_rg_a': nrm(ks[6], (L, RNN_BLOCKS, RNN_BLOCK), 0.02),
        'w_rg_x': nrm(ks[7], (L, RNN_BLOCKS, RNN_BLOCK, RNN_BLOCK), RNN_BLOCK ** -0.5),
        'b_rg_x': nrm(ks[8], (L, RNN_BLOCKS, RNN_BLOCK), 0.02),
        'lru_lambda': jnp.log(a0) - jnp.log1p(-a0),
        'diff_lambda_q1': nrm(ks[10], (L, HEAD_DIM), 0.1),
        'diff_lambda_k1': nrm(ks[11], (L, HEAD_DIM), 0.1),
        'diff_lambda_q2': nrm(ks[12], (L, HEAD_DIM), 0.1),
        'diff_lambda_k2': nrm(ks[13], (L, HEAD_DIM), 0.1),
        'subln_g': 1.0 + nrm(ks[14], (L, V_DIM), 0.05),
        'rel_bias_table': nrm(ks[15], (NUM_BUCKETS, N_HEADS), 0.3),
        'w_proj_rnn': nrm(ks[16], (L, D_RNN, D_MODEL), D_RNN ** -0.5),
        'w_proj_att': nrm(ks[17], (L, ATT_V, D_MODEL), ATT_V ** -0.5),
        'w_out': nrm(ks[18], (L, D_MODEL, D_MODEL), D_MODEL ** -0.5),
        'norm_ffn_g': 1.0 + nrm(ks[19], (L, D_MODEL), 0.05),
        'w_router': nrm(ks[20], (L, D_MODEL, N_EXPERTS), D_MODEL ** -0.5),
        'b_router': nrm(ks[21], (L, N_EXPERTS), 0.01),
        'w_gate_e': nrm(ks[22], (L, N_EXPERTS, D_MODEL, D_FF), D_MODEL ** -0.5),
        'b_gate_e': nrm(ks[23], (L, N_EXPERTS, D_FF), 0.02),
        'w_up_e': nrm(ks[24], (L, N_EXPERTS, D_MODEL, D_FF), D_MODEL ** -0.5),
        'b_up_e': nrm(ks[25], (L, N_EXPERTS, D_FF), 0.02),
        'w_down_e': nrm(ks[26], (L, N_EXPERTS, D_FF, D_MODEL), D_FF ** -0.5),
        'b_down_e': nrm(ks[27], (L, N_EXPERTS, D_MODEL), 0.02),
        'norm_final_g': 1.0 + nrm(ks[28], (D_MODEL,), 0.05),
    }


def reference(x, norm_mix_g, w_in, conv_w, conv_b, w_rg_a, b_rg_a, w_rg_x, b_rg_x, lru_lambda, diff_lambda_q1, diff_lambda_k1, diff_lambda_q2, diff_lambda_k2, subln_g, rel_bias_table, w_proj_rnn, w_proj_att, w_out, norm_ffn_g, w_router, b_router, w_gate_e, b_gate_e, w_up_e, b_up_e, w_down_e, b_down_e, norm_final_g):
    B, S, D = x.shape
    o0 = 0
    o1 = o0 + D_RNN
    o2 = o1 + D_RNN
    o3 = o2 + ATT_QK
    o4 = o3 + ATT_QK
    o5 = o4 + ATT_V
    for l in range(DEPTH):
        h = rms_norm(x, norm_mix_g[l])
        proj = h @ w_in[l]
        xr, gr = proj[..., o0:o1], proj[..., o1:o2]
        q = proj[..., o2:o3].reshape(B, S, N_HEADS, 2, HEAD_DIM)
        k = proj[..., o3:o4].reshape(B, S, N_HEADS, 2, HEAD_DIM)
        v = proj[..., o4:o5].reshape(B, S, N_HEADS, V_DIM)
        gates = jax.nn.sigmoid(proj[..., o5:].reshape(B, S, N_BRANCH, D_MODEL))

        y_rnn = rglru_branch(xr, gr, conv_w[l], conv_b[l], w_rg_a[l], b_rg_a[l], w_rg_x[l], b_rg_x[l], lru_lambda[l])
        lam_init = lambda_init(l)
        lam = (jnp.exp(jnp.sum(diff_lambda_q1[l].astype(jnp.float32) * diff_lambda_k1[l].astype(jnp.float32)))
               - jnp.exp(jnp.sum(diff_lambda_q2[l].astype(jnp.float32) * diff_lambda_k2[l].astype(jnp.float32))) + lam_init)
        y_att = diff_attention(q, k, v, lam, lam_init, subln_g[l], rel_bias_table)

        merged = gates[..., 0, :] * (y_rnn @ w_proj_rnn[l]) + gates[..., 1, :] * (y_att @ w_proj_att[l])
        x = x + merged @ w_out[l]
        hf = rms_norm(x, norm_ffn_g[l])
        x = x + moe_ffn(hf, w_router[l], b_router[l], w_gate_e[l], b_gate_e[l], w_up_e[l], b_up_e[l], w_down_e[l], b_down_e[l])
    return rms_norm(x, norm_final_g)
```

```cpp
#include <hip/hip_runtime.h>
#include <cstdio>
#include <cstdint>
#include <cmath>

#ifndef MK_N_LAUNCHES
#define MK_N_LAUNCHES 1
#endif

#define GAS __attribute__((address_space(1)))
#define LAS __attribute__((address_space(3)))
typedef unsigned short bf16_t;
typedef short bf16x8 __attribute__((ext_vector_type(8)));
typedef short s16x4 __attribute__((ext_vector_type(4)));
typedef float f32x2 __attribute__((ext_vector_type(2)));
typedef float f32x4 __attribute__((ext_vector_type(4)));
typedef float f32x16 __attribute__((ext_vector_type(16)));
typedef unsigned u32x2 __attribute__((ext_vector_type(2)));
typedef unsigned u32x4 __attribute__((ext_vector_type(4)));
typedef __bf16 bf16x2_t __attribute__((ext_vector_type(2)));
typedef GAS unsigned gu32;

constexpr int BATCH = 8, SEQ = 4096, D = 1024, T = BATCH * SEQ;
constexpr int DIN = 7168, NH = 8, NEXP = 32, TOPK = 4, NPAIR = T * TOPK;
constexpr float EPS = 1e-6f, LOG2E = 1.4426950408889634f;
constexpr float QSCALE = 0.125f * LOG2E;
constexpr float LAM_INIT = 0.2f;

constexpr size_t MiB = 1u << 20;
constexpr size_t WS_CTL = 0, CTL_ZERO_BYTES = 64 * 1024;
constexpr size_t WS_MISC = 1 * MiB;
constexpr size_t WS_WIN_T = 2 * MiB;
constexpr size_t WS_LIST = 2 * MiB, WS_RS = 6 * MiB, WS_WT = 10 * MiB;
constexpr size_t WS_WRNN_T = 16 * MiB, WS_WATT_T = 18 * MiB, WS_WOUT_T = 20 * MiB;
constexpr size_t UNIT = 64 * MiB;
constexpr size_t WS_U(int i) { return 24 * MiB + (size_t)(i - 1) * UNIT; }
constexpr size_t WS_S = 536 * MiB;
constexpr size_t WS_END = 552 * MiB;
constexpr size_t MS_RFRAG = 0;
constexpr size_t MS_BT = 128 * 1024;
constexpr size_t MS_SP = 132 * 1024;
constexpr size_t MS_LAM = 136 * 1024;
constexpr size_t MS_BMAX = 140 * 1024;
constexpr int CW_TMO = 0, CW_CODE = 1, CW_QUEUE = 64, CW_CNT = 128  , CW_KM2 = 256  , CW_BAR = 4096;

constexpr int RING_BYTES = 131072, LDSCTL_OFF = RING_BYTES, LDS_BYTES = 147456;
constexpr int LW_BAR = 0  , LW_Q = 8  , LW_TS = 16  , LW_CNT = 64  , LW_MISC = 128;

#define RLX_AGENT __ATOMIC_RELAXED, __HIP_MEMORY_SCOPE_AGENT
#define LDS_WAIT() asm volatile("s_waitcnt lgkmcnt(0)" ::: "memory")
#define VM_WAIT() asm volatile("s_waitcnt vmcnt(0)" ::: "memory")
#define WG_BAR() asm volatile("s_waitcnt vmcnt(0) lgkmcnt(0)\n\ts_barrier" ::: "memory")
#define SBAR() __builtin_amdgcn_sched_barrier(0)
__device__ __forceinline__ unsigned cvtpk(float lo, float hi) { f32x2 v = {lo, hi}; bf16x2_t b = __builtin_convertvector(v, bf16x2_t); return __builtin_bit_cast(unsigned, b); }
__device__ __forceinline__ unsigned cvt4_fp8(float a, float b, float c, float d) { unsigned w = 0u; w = __builtin_amdgcn_cvt_pk_fp8_f32(a, b, w, false); w = __builtin_amdgcn_cvt_pk_fp8_f32(c, d, w, true); return w; }
__device__ __forceinline__ float bf2f(unsigned short h) { return __uint_as_float((unsigned)h << 16); }
__device__ __forceinline__ float bflo(unsigned w) { return __uint_as_float(w << 16); }
__device__ __forceinline__ float bfhi(unsigned w) { return __uint_as_float(w & 0xffff0000u); }
__device__ __forceinline__ float fast_exp2(float x) { return __builtin_amdgcn_exp2f(x); }
__device__ __forceinline__ float fast_rcp(float x) { return __builtin_amdgcn_rcpf(x); }
__device__ __forceinline__ float sigmoidf_(float x) { return fast_rcp(1.0f + fast_exp2(-x * LOG2E)); }
__device__ __forceinline__ float wave_sum(float v) {
#pragma unroll
    for (int o = 1; o < 64; o <<= 1) v += __shfl_xor(v, o);
    return v;
}

namespace pg8 {
constexpr int BM = 256, BK = 64, HALF = 128, HTB = HALF * BK * 2, STAGE_BYTES = 8 * HTB, KD = 1024;
__host__ __device__ __forceinline__ int lds_byte(int r, int c) { const int st = (r >> 4) * 2 + (c >> 5), rr = r & 15, cc = c & 31, ob = rr * 64 + cc * 2; return st * 1024 + (ob ^ (((ob >> 9) & 1) << 5)); }
__host__ __device__ __forceinline__ void stage_rc(int b, int& R, int& C) { const int st = b / 1024, sb = b % 1024, swz = sb ^ (((sb >> 9) & 1) << 5); R = (st >> 1) * 16 + swz / 64; C = (st & 1) * 32 + (swz % 64) / 2; }
__host__ __device__ __forceinline__ int perm32(int rho) { const int n = rho >> 4, i = rho & 15; return 8 * (i >> 2) + 4 * n + (i & 3); }

__host__ __device__ __forceinline__ size_t btile_off(int n, int kb, int ntb) {
    const int x = n & 31, rho = 16 * ((x >> 2) & 1) + 4 * (x >> 3) + (x & 3), slot = (n & 96) + rho;
    return ((size_t)(n >> 7) * ntb + (kb >> 7)) * 16384 + lds_byte(slot, (kb & 127) >> 1) + (kb & 1);
}
struct UnitG { const char* A; const char* B0; const char* B1; unsigned tk0, tk1; int x0, x1, x2, x3, x4; };

struct TileOrder {
    int nM, nN, nwg, G, c;
    __device__ void init(int M, int N, int G_, int c_) { nM = M / BM; nN = N / BM; nwg = nM * nN; G = G_; c = c_; }
    __device__ bool tile(int i, int& pm, int& pn) const {
        const long L = (long)i * G + c; if (L >= nwg) return false;
        int wgid = (int)L; { const int q = nwg / 8, r = nwg % 8, xcd = wgid % 8, off = wgid / 8; wgid = (xcd < r ? xcd * (q + 1) : r * (q + 1) + (xcd - r) * q) + off; }
        const int nig = 8 * nN, gid = wgid / nig, fm = gid * 8, gsz = (nM - fm) < 8 ? (nM - fm) : 8;
        pm = fm + ((wgid % nig) % gsz); pn = (wgid % nig) / gsz; return true;
    }
};
struct DenseSched {
    TileOrder O; const char* A; const char* Bt;
    __device__ bool next(int i, UnitG& u) const {
        int pm, pn; if (!O.tile(i, pm, pn)) return false;
        u.A = A + (size_t)pm * (BM * KD * 2); u.B0 = Bt + (size_t)pn * (BM * KD * 2); u.B1 = u.B0 + (size_t)HALF * KD * 2;
        u.tk0 = 0u; u.tk1 = 0u; u.x0 = pm; u.x1 = pn; u.x2 = 0; u.x3 = 0; u.x4 = 0; return true;
    }
    __device__ __forceinline__ void expand(const UnitG&, unsigned& o0, unsigned& o1, unsigned& o2, unsigned& o3) const {
        int R, C; stage_rc((int)threadIdx.x * 16, R, C); o0 = (unsigned)(R * KD + C) * 2u; stage_rc((int)threadIdx.x * 16 + 8192, R, C); o1 = (unsigned)(R * KD + C) * 2u;
        o2 = o0 + (unsigned)(HALF * KD * 2); o3 = o1 + (unsigned)(HALF * KD * 2);
    }
};

typedef int i32x4 __attribute__((ext_vector_type(4)));
typedef int i32x8 __attribute__((ext_vector_type(8)));
__device__ __forceinline__ i32x8 cat8(const bf16x8 a, const bf16x8 b) { return __builtin_shufflevector(__builtin_bit_cast(i32x4, a), __builtin_bit_cast(i32x4, b), 0, 1, 2, 3, 4, 5, 6, 7); }
struct DualSched {
    TileOrder O; const char* A0; const char* Bt0; const char* A1; const char* Bt1;
    __device__ bool next(int i, UnitG& u) const {
        int pm, pn; if (!O.tile(i >> 1, pm, pn)) return false;
        const int g = i & 1;
        u.A = (g ? A1 : A0) + (size_t)pm * (BM * KD * 2); u.B0 = (g ? Bt1 : Bt0) + (size_t)pn * (BM * KD * 2); u.B1 = u.B0 + (size_t)HALF * KD * 2;
        u.tk0 = 0u; u.tk1 = 0u; u.x0 = pm; u.x1 = pn; u.x2 = g; u.x3 = 0; u.x4 = 0; return true;
    }
    __device__ __forceinline__ void expand(const UnitG&, unsigned& o0, unsigned& o1, unsigned& o2, unsigned& o3) const {
        int R, C; stage_rc((int)threadIdx.x * 16, R, C); o0 = (unsigned)(R * KD + C) * 2u; stage_rc((int)threadIdx.x * 16 + 8192, R, C); o1 = (unsigned)(R * KD + C) * 2u;
        o2 = o0 + (unsigned)(HALF * KD * 2); o3 = o1 + (unsigned)(HALF * KD * 2);
    }
};
template <class Epi, class Sched, bool FP8 = false>
__device__ __forceinline__ void gemm_phase(LAS unsigned char* lds, const Sched& S, const Epi& E) {
    constexpr int PB = FP8 ? 1024 : 2048, NT = FP8 ? 8 : 16;
    const int tid = threadIdx.x, wid = __builtin_amdgcn_readfirstlane(tid >> 6), lane = tid & 63, wr = wid >> 2, wc = wid & 3, fr = lane & 15, fq = lane >> 4;
    static_assert(Epi::PERM, "weights are stored in the PERM tiled layout");
    const unsigned voffB0 = (unsigned)tid * 16u;
    constexpr size_t kstep = (size_t)(BK * 2), kstepB = 16384;
    const unsigned ldsw = (unsigned)wid * 1024u;
    const int aoff = lds_byte(wr * 64 + fr, fq * 8), boff = lds_byte(wc * 32 + fr, fq * 8);
#define PG8_SA(b, h) (((b) * 2 + (h)) * HTB)
#define PG8_SB(b, h) ((4 + (b) * 2 + (h)) * HTB)
#define PG8_STAGEB(bufoff, gbase) do { _Pragma("unroll") for (int _i = 0; _i < 2; ++_i) \
        __builtin_amdgcn_global_load_lds((const GAS unsigned*)((const char*)(gbase) + voffB0 + _i * 8192), (LAS unsigned*)(lds + (bufoff) + ldsw + _i * 8192), 16, 0, 0); } while (0)
#define PG8_STAGEA(bufoff, gbase, oa, ob) do { \
        __builtin_amdgcn_global_load_lds((const GAS unsigned*)((const char*)(gbase) + (oa)), (LAS unsigned*)(lds + (bufoff) + ldsw), 16, 0, 0); \
        __builtin_amdgcn_global_load_lds((const GAS unsigned*)((const char*)(gbase) + (ob)), (LAS unsigned*)(lds + (bufoff) + ldsw + 8192), 16, 0, 0); } while (0)
#define PG8_LDA(dst, b, h) do { _Pragma("unroll") for (int m = 0; m < 4; ++m) { const i32x4 l0_ = *(const LAS i32x4*)(lds + PG8_SA(b, h) + aoff + m * 2048), l1_ = *(const LAS i32x4*)(lds + PG8_SA(b, h) + aoff + m * 2048 + 1024); dst[m] = __builtin_shufflevector(l0_, l1_, 0, 1, 2, 3, 4, 5, 6, 7); } } while (0)
#define PG8_LDB(dst, b, h) do { _Pragma("unroll") for (int n = 0; n < 2; ++n) { const i32x4 l0_ = *(const LAS i32x4*)(lds + PG8_SB(b, h) + boff + n * 2048), l1_ = *(const LAS i32x4*)(lds + PG8_SB(b, h) + boff + n * 2048 + 1024); dst[n] = __builtin_shufflevector(l0_, l1_, 0, 1, 2, 3, 4, 5, 6, 7); } } while (0)
#define PG8_HALF(v, k) __builtin_bit_cast(bf16x8, __builtin_shufflevector(v, v, 4 * (k), 4 * (k) + 1, 4 * (k) + 2, 4 * (k) + 3))
#define PG8_MMA(ai, bj, At, Bt) do { __builtin_amdgcn_s_setprio(1); _Pragma("unroll") for (int m = 0; m < 4; ++m) _Pragma("unroll") for (int n = 0; n < 2; ++n) { \
        if constexpr (FP8) acc[ai][bj][m][n] = __builtin_amdgcn_mfma_scale_f32_16x16x128_f8f6f4(Bt[n], At[m], acc[ai][bj][m][n], 0, 0, 0, 0x7f7f7f7f, 0, 0x7f7f7f7f); \
        else { acc[ai][bj][m][n] = __builtin_amdgcn_mfma_f32_16x16x32_bf16(PG8_HALF(Bt[n], 0), PG8_HALF(At[m], 0), acc[ai][bj][m][n], 0, 0, 0); acc[ai][bj][m][n] = __builtin_amdgcn_mfma_f32_16x16x32_bf16(PG8_HALF(Bt[n], 1), PG8_HALF(At[m], 1), acc[ai][bj][m][n], 0, 0, 0); } } __builtin_amdgcn_s_setprio(0); } while (0)
#define PG8_WAIT_V(n) asm volatile("s_waitcnt vmcnt(" #n ")" ::: "memory")
#define PG8_WAIT_L(n) asm volatile("s_waitcnt lgkmcnt(" #n ")" ::: "memory")
#define PG8_BAR __builtin_amdgcn_s_barrier()
#define PG8_SCHED __builtin_amdgcn_sched_barrier(0)
    UnitG cur, nxt; int ui = 0;
    if (!S.next(0, cur)) return;
    f32x4 acc[2][2][4][2];
#pragma unroll
    for (int a = 0; a < 2; ++a)
#pragma unroll
        for (int b = 0; b < 2; ++b)
#pragma unroll
            for (int m = 0; m < 4; ++m)
#pragma unroll
                for (int n = 0; n < 2; ++n) acc[a][b][m][n] = (f32x4){0.f, 0.f, 0.f, 0.f};
    i32x8 At[4], B0[2], B1[2];
    const char* cA = cur.A; const char* cB0 = cur.B0; const char* cB1 = cur.B1;
    unsigned ca0, ca1, ca2, ca3; S.expand(cur, ca0, ca1, ca2, ca3);
    PG8_STAGEB(PG8_SB(0, 0), cB0); PG8_STAGEB(PG8_SB(0, 1), cB1); PG8_STAGEA(PG8_SA(0, 0), cA, ca0, ca1); PG8_STAGEA(PG8_SA(0, 1), cA, ca2, ca3);
    if (wr == 1) PG8_BAR;
    PG8_WAIT_V(2); PG8_BAR;
    PG8_STAGEB(PG8_SB(1, 0), cB0 + kstepB); PG8_STAGEA(PG8_SA(1, 0), cA + kstep, ca0, ca1); PG8_STAGEB(PG8_SB(1, 1), cB1 + kstepB);
    PG8_WAIT_V(6); PG8_BAR;
    for (;;) {
        const bool has_next = S.next(ui + 1, nxt);
        const char* nA = has_next ? nxt.A : cA; const char* nB0 = has_next ? nxt.B0 : cB0; const char* nB1 = has_next ? nxt.B1 : cB1;
#pragma unroll 1
        for (int t = 0; t < NT; t += 2) {
            const bool last = (t == NT - 2);
            const char* a1 = cA + (size_t)(t + 1) * kstep;
            const char* a2 = last ? nA : cA + (size_t)(t + 2) * kstep;
            const char* b02 = last ? nB0 : cB0 + (size_t)(t + 2) * kstepB; const char* b12 = last ? nB1 : cB1 + (size_t)(t + 2) * kstepB;
            const char* a3 = a2 + kstep; const char* b03 = b02 + kstepB; const char* b13 = b12 + kstepB;
            PG8_LDB(B0, 0, 0); PG8_LDB(B1, 0, 1); PG8_SCHED; PG8_LDA(At, 0, 0); PG8_STAGEA(PG8_SA(1, 1), a1, ca2, ca3);
            if (last && has_next) S.expand(nxt, ca0, ca1, ca2, ca3);
            if constexpr (Epi::NSTORES == 16) { if (t == 0 && ui > 0) PG8_WAIT_V(24); else PG8_WAIT_V(8); } else PG8_WAIT_V(8);
            PG8_WAIT_L(0); PG8_BAR; PG8_MMA(0, 0, At, B0); PG8_MMA(0, 1, At, B1); PG8_BAR; PG8_SCHED;
            PG8_LDA(At, 0, 1); PG8_STAGEB(PG8_SB(0, 0), b02); PG8_STAGEB(PG8_SB(0, 1), b12); PG8_STAGEA(PG8_SA(0, 0), a2, ca0, ca1);
            if constexpr (Epi::NSTORES == 16) { if (t == 0 && ui > 0) PG8_WAIT_V(24); else PG8_WAIT_V(8); } else PG8_WAIT_V(8);
            PG8_WAIT_L(0); PG8_BAR; PG8_MMA(1, 0, At, B0); PG8_MMA(1, 1, At, B1); PG8_BAR; PG8_SCHED;
            PG8_LDB(B0, 1, 0); PG8_LDB(B1, 1, 1); PG8_SCHED; PG8_LDA(At, 1, 0); PG8_STAGEA(PG8_SA(0, 1), a2, ca2, ca3);
            PG8_WAIT_V(8); PG8_WAIT_L(0); PG8_BAR; PG8_MMA(0, 0, At, B0); PG8_MMA(0, 1, At, B1); PG8_BAR; PG8_SCHED;
            PG8_LDA(At, 1, 1); PG8_STAGEB(PG8_SB(1, 0), b03); PG8_STAGEB(PG8_SB(1, 1), b13); PG8_STAGEA(PG8_SA(1, 0), a3, ca0, ca1);
            PG8_WAIT_V(8); PG8_WAIT_L(0); PG8_BAR; PG8_MMA(1, 0, At, B0); PG8_MMA(1, 1, At, B1); PG8_BAR; PG8_SCHED;
        }
        if (wr == 0) PG8_BAR;
        E(acc, cur, wr, wc, fr, fq);
        if (!has_next) break;
#pragma unroll
        for (int a = 0; a < 2; ++a)
#pragma unroll
            for (int b = 0; b < 2; ++b)
#pragma unroll
                for (int m = 0; m < 4; ++m)
#pragma unroll
                    for (int n = 0; n < 2; ++n) acc[a][b][m][n] = (f32x4){0.f, 0.f, 0.f, 0.f};
        cur = nxt; cA = nA; cB0 = nB0; cB1 = nB1;
        ++ui;
        if (wr == 1) PG8_BAR;
    }
    PG8_WAIT_V(0);
    PG8_BAR;
#undef PG8_SA
#undef PG8_SB
#undef PG8_STAGEA
#undef PG8_STAGEB
#undef PG8_LDA
#undef PG8_LDB
#undef PG8_MMA
#undef PG8_WAIT_V
#undef PG8_WAIT_L
#undef PG8_BAR
#undef PG8_SCHED
}
}

namespace epi {
using pg8::UnitG;
__device__ __forceinline__ u32x4 pack8(const f32x4 v0, const f32x4 v1) { u32x4 w; w.x = cvtpk(v0[0], v0[1]); w.y = cvtpk(v0[2], v0[3]); w.z = cvtpk(v1[0], v1[1]); w.w = cvtpk(v1[2], v1[3]); return w; }
__device__ __forceinline__ void unpack8(const u32x4 w, f32x4& v0, f32x4& v1) { v0 = (f32x4){bflo(w.x), bfhi(w.x), bflo(w.y), bfhi(w.y)}; v1 = (f32x4){bflo(w.z), bfhi(w.z), bflo(w.w), bfhi(w.w)}; }

struct EpiProj {
    static constexpr bool PERM = true; static constexpr int NSTORES = 0;
    bf16_t* out[7]; int dbg; unsigned* km2;
    __device__ __forceinline__ void operator()(const f32x4 (&acc)[2][2][4][2], const UnitG& u, int wr, int wc, int fr, int fq) const {
        asm volatile("" : "+v"(fr), "+v"(fq));
        const int reg = u.x1 >> 2; bf16_t* base = reg == 0 ? out[0] : reg == 1 ? out[1] : reg == 2 ? out[2] : reg == 3 ? out[3] : reg == 4 ? out[4] : reg == 5 ? out[5] : out[6];
        const int row0 = u.x0 * 256 + wr * 64 + fr, col0 = (u.x1 & 3) * 256 + wc * 32 + 8 * fq;
        float kss[2] = {0.f, 0.f};
#pragma unroll
        for (int ai = 0; ai < 2; ++ai)
#pragma unroll
            for (int m = 0; m < 4; ++m) { const int row = row0 + ai * 128 + m * 16; bf16_t* rowp = base + (size_t)row * D + col0;
                const int bq = row >> 12, sq = row & 4095, tile = sq >> 6, key = sq & 63;
#pragma unroll
                for (int bj = 0; bj < 2; ++bj) { f32x4 v0 = acc[ai][bj][m][0], v1 = acc[ai][bj][m][1];
                    if (reg >= 5) {
#pragma unroll
                        for (int j = 0; j < 4; ++j) { v0[j] = sigmoidf_(v0[j]); v1[j] = sigmoidf_(v1[j]); } }
                    else if (reg == 2) { v0 = v0 * QSCALE; v1 = v1 * QSCALE; }
                    u32x4* dst = (u32x4*)(rowp + bj * 128);
                    if (reg == 3 || reg == 4) { const int col = col0 + bj * 128, hh = col >> 7;
                        const size_t off16 = (reg == 3) ? ((((size_t)((bq * 8 + hh) * 2 + ((col >> 6) & 1)) * 64 + tile) * 8 + ((col >> 3) & 7)) * 64 + key)
                                                        : ((((size_t)(bq * 8 + hh) * 64 + tile) * 16 + ((col >> 5) & 3) * 4 + (key >> 4)) * 64 + (key & 15) * 4 + ((col >> 3) & 3));
                        dst = (u32x4*)base + off16; }
                    if (!(dbg & 1)) __builtin_nontemporal_store(pack8(v0, v1), dst);
                    if (reg == 3) { kss[bj] = fmaxf(kss[bj], (v0[0] * v0[0] + v0[1] * v0[1]) + (v0[2] * v0[2] + v0[3] * v0[3]) + (v1[0] * v1[0] + v1[1] * v1[1]) + (v1[2] * v1[2] + v1[3] * v1[3])); } } }
        if (reg == 3) {
#pragma unroll
            for (int bj = 0; bj < 2; ++bj) { float s = kss[bj];
                s += __shfl_xor(s, 16); s += __shfl_xor(s, 32);
#pragma unroll
                for (int of = 1; of < 16; of <<= 1) s = fmaxf(s, __shfl_xor(s, of));
                if ((fr | fq) == 0) __hip_atomic_fetch_max(km2 + (((u.x0 >> 4) * 8 + (u.x1 & 3) * 2 + bj) * 2 + (wc >> 1)) * 2 + (wc & 1), __float_as_uint(s), RLX_AGENT); } }
    }
};
template <bool GATE, bool ADD> struct EpiGate {
    static constexpr bool PERM = true; static constexpr int NSTORES = 0;
    bf16_t* out; const bf16_t* gate; const bf16_t* addsrc;
    __device__ __forceinline__ void operator()(const f32x4 (&acc)[2][2][4][2], const UnitG& u, int wr, int wc, int fr, int fq) const {
        asm volatile("" : "+v"(fr), "+v"(fq));
        const int row0 = u.x0 * 256 + wr * 64 + fr, col0 = u.x1 * 256 + wc * 32 + 8 * fq;
#pragma unroll
        for (int ai = 0; ai < 2; ++ai)
#pragma unroll
            for (int m = 0; m < 4; ++m) { const size_t off = (size_t)(row0 + ai * 128 + m * 16) * D + col0;
#pragma unroll
                for (int bj = 0; bj < 2; ++bj) { f32x4 v0 = acc[ai][bj][m][0], v1 = acc[ai][bj][m][1];
                    if (GATE) { f32x4 g0, g1; unpack8(*(const u32x4*)(gate + off + bj * 128), g0, g1); v0 = v0 * g0; v1 = v1 * g1; }
                    if (ADD) { f32x4 a0, a1; unpack8(*(const u32x4*)(addsrc + off + bj * 128), a0, a1); v0 = v0 + a0; v1 = v1 + a1; }
                    *(u32x4*)(out + off + bj * 128) = pack8(v0, v1); } }
    }
};
struct EpiMerge {
    static constexpr bool PERM = true; static constexpr int NSTORES = 0;
    bf16_t* m1; bf16_t* out; const bf16_t* g0; const bf16_t* g1;
    __device__ __forceinline__ void operator()(const f32x4 (&acc)[2][2][4][2], const UnitG& u, int wr, int wc, int fr, int fq) const {
        asm volatile("" : "+v"(fr), "+v"(fq));
        const int row0 = u.x0 * 256 + wr * 64 + fr, col0 = u.x1 * 256 + wc * 32 + 8 * fq; const bool second = u.x2 != 0;
        const bf16_t* gate = second ? g1 : g0; bf16_t* dst = second ? out : m1;
#pragma unroll
        for (int ai = 0; ai < 2; ++ai)
#pragma unroll
            for (int m = 0; m < 4; ++m) { const size_t off = (size_t)(row0 + ai * 128 + m * 16) * D + col0;
#pragma unroll
                for (int bj = 0; bj < 2; ++bj) { f32x4 v0 = acc[ai][bj][m][0], v1 = acc[ai][bj][m][1];
                    f32x4 ga, gb; unpack8(*(const u32x4*)(gate + off + bj * 128), ga, gb); v0 = v0 * ga; v1 = v1 * gb;
                    if (second) { f32x4 a0, a1; unpack8(*(const u32x4*)(m1 + off + bj * 128), a0, a1); v0 = v0 + a0; v1 = v1 + a1; }
                    *(u32x4*)(dst + off + bj * 128) = pack8(v0, v1); } }
    }
};
struct EpiGU {
    static constexpr bool PERM = true; static constexpr int NSTORES = 0;
    const float* bg; const float* bu; const float* rs; unsigned char* actbase[2];
    __device__ __forceinline__ void operator()(const f32x4 (&acc)[2][2][4][2], const UnitG& u, int wr, int wc, int fr, int fq) const {
        asm volatile("" : "+v"(fr), "+v"(fq));
        const int tile = u.x0, e = u.x2, rl0 = u.x3, nval = u.x4;
        const int ff0 = u.x1 * 128 + wc * 32 + 8 * fq;
        const f32x4 bg0 = *(const f32x4*)(bg + e * D + ff0), bg1 = *(const f32x4*)(bg + e * D + ff0 + 4), bu0 = *(const f32x4*)(bu + e * D + ff0), bu1 = *(const f32x4*)(bu + e * D + ff0 + 4);
        unsigned char* abase = ((tile >> 9) == 0 ? actbase[0] : actbase[1]) + (size_t)(tile & 511) * (256 * D);
        const float* rsp = rs + (size_t)e * T + rl0;
        float rsv[8];
#pragma unroll
        for (int i = 0; i < 8; ++i) { const int r = (i >> 2) * 128 + wr * 64 + (i & 3) * 16 + fr; rsv[i] = (r < nval) ? rsp[r] * (1.0f / 32.0f) : 0.f; }
#pragma unroll
        for (int ai = 0; ai < 2; ++ai)
#pragma unroll
            for (int m = 0; m < 4; ++m) { const int r = ai * 128 + wr * 64 + m * 16 + fr;
                const float rstd = rsv[ai * 4 + m];
                f32x4 g0 = acc[ai][0][m][0] * rstd + bg0, g1 = acc[ai][0][m][1] * rstd + bg1, u0 = acc[ai][1][m][0] * rstd + bu0, u1 = acc[ai][1][m][1] * rstd + bu1;
#pragma unroll
                for (int j = 0; j < 4; ++j) {
                    { const float gm = fminf(g0[j], 7.0f), uc = fminf(fmaxf(u0[j], -7.0f), 7.0f); g0[j] = (4.0f * uc + 4.0f) * (gm * fast_rcp(1.0f + fast_exp2(gm * (-1.702f * LOG2E)))); }
                    { const float gm = fminf(g1[j], 7.0f), uc = fminf(fmaxf(u1[j], -7.0f), 7.0f); g1[j] = (4.0f * uc + 4.0f) * (gm * fast_rcp(1.0f + fast_exp2(gm * (-1.702f * LOG2E)))); } }
                u32x2 w; w.x = cvt4_fp8(g0[0], g0[1], g0[2], g0[3]); w.y = cvt4_fp8(g1[0], g1[1], g1[2], g1[3]);
                *(u32x2*)(abase + (size_t)r * D + ff0) = w; }
    }
};
struct EpiDown {
    static constexpr bool PERM = true; static constexpr int NSTORES = 16;
    const float* bd; const float* wt; const unsigned* list; unsigned char* ybase; unsigned char* junk;
    __device__ __forceinline__ void operator()(const f32x4 (&acc)[2][2][4][2], const UnitG& u, int wr, int wc, int fr, int fq) const {
        asm volatile("" : "+v"(fr), "+v"(fq));
        const int e = u.x2, rl0 = u.x3, nval = u.x4;
        const int c0 = u.x1 * 256 + wc * 32 + 8 * fq;
        f32x4 bv[2][2];
#pragma unroll
        for (int bj = 0; bj < 2; ++bj) { bv[bj][0] = *(const f32x4*)(bd + e * D + c0 + bj * 128); bv[bj][1] = *(const f32x4*)(bd + e * D + c0 + bj * 128 + 4); }
        const float* wtp = wt + (size_t)e * T + rl0; const unsigned* lp = list + (size_t)e * T + rl0;
        unsigned pr[8]; float wv[8];
#pragma unroll
        for (int i = 0; i < 8; ++i) { const int r = (i >> 2) * 128 + wr * 64 + (i & 3) * 16 + fr; const bool ok = r < nval; pr[i] = ok ? lp[r] : 0xffffffffu; wv[i] = ok ? wtp[r] : 0.f; }
#pragma unroll
        for (int ai = 0; ai < 2; ++ai)
#pragma unroll
            for (int m = 0; m < 4; ++m) { const unsigned pair = pr[ai * 4 + m]; const float w = wv[ai * 4 + m];
                {   const bool ok = pair != 0xffffffffu;
                    const unsigned yo = (ok ? pair * 2048u : 0u) + (unsigned)c0 * 2u;
                    unsigned char* yb_ = ok ? ybase : junk;
#pragma unroll
                    for (int bj = 0; bj < 2; ++bj) { const f32x4 v0 = (acc[ai][bj][m][0] * (1.0f / 128.0f) + bv[bj][0]) * w, v1 = (acc[ai][bj][m][1] * (1.0f / 128.0f) + bv[bj][1]) * w; __builtin_nontemporal_store(pack8(v0, v1), (u32x4*)(yb_ + yo + bj * 256)); } } }
    }
};
template <int NPN, bool GATHER> struct MoeSched {
    int G, c, ntl; const LAS int* ts; const LAS int* cn;
    const char* A; const unsigned* list; const char* W0; const char* W1; unsigned char* actbase[2];
    __device__ bool next(int i, UnitG& u) const {
        const int uu = i * G + c, xq = uu & 7, rk = uu >> 3, tile = xq + 8 * (rk / NPN), pn = rk % NPN;
        if (tile >= ntl) return false;
        int e = 0;
#pragma unroll
        for (int st = 16; st >= 1; st >>= 1) { if (ts[e + st] <= tile) e += st; }
        e = __builtin_amdgcn_readfirstlane(e);
        const int rl0 = __builtin_amdgcn_readfirstlane((tile - ts[e]) * 256), nval = __builtin_amdgcn_readfirstlane(cn[e]) - rl0;
        u.x0 = tile; u.x1 = pn; u.x2 = e; u.x3 = rl0; u.x4 = nval;
        if (GATHER) {
            u.A = A; u.B0 = W0 + ((size_t)e * 1024 + pn * 128) * 1024; u.B1 = W1 + ((size_t)e * 1024 + pn * 128) * 1024;
            int R, C; pg8::stage_rc((int)threadIdx.x * 16, R, C);
            unsigned tk[4];
#pragma unroll
            for (int j = 0; j < 4; ++j) { const int r = (j >> 1) * 128 + (j & 1) * 64 + R; tk[j] = (r < nval) ? (list[(size_t)e * T + rl0 + r] >> 2) : 0u; }
            u.tk0 = tk[0] | (tk[1] << 16); u.tk1 = tk[2] | (tk[3] << 16);
        } else {
            u.A = (const char*)(((tile >> 9) == 0 ? actbase[0] : actbase[1]) + (size_t)(tile & 511) * (256 * D)); u.B0 = W0 + ((size_t)e * 1024 + pn * 256) * 1024; u.B1 = u.B0 + (size_t)128 * 1024;
            u.tk0 = 0u; u.tk1 = 0u;
        }
        return true;
    }
    __device__ __forceinline__ void expand(const UnitG& u, unsigned& o0, unsigned& o1, unsigned& o2, unsigned& o3) const {
        int R, C0, C1; pg8::stage_rc((int)threadIdx.x * 16, R, C0); pg8::stage_rc((int)threadIdx.x * 16 + 8192, R, C1);
        if (GATHER) { o0 = (u.tk0 & 0xffffu) * 1024u + (unsigned)C0 * 2u; o1 = (u.tk0 >> 16) * 1024u + (unsigned)C1 * 2u; o2 = (u.tk1 & 0xffffu) * 1024u + (unsigned)C0 * 2u; o3 = (u.tk1 >> 16) * 1024u + (unsigned)C1 * 2u; }
        else { pg8::stage_rc((int)threadIdx.x * 16, R, C0); o0 = (unsigned)(R * 1024 + C0 * 2); o1 = (unsigned)((R + 64) * 1024 + C1 * 2); o2 = o0 + 128u * 1024u; o3 = o1 + 128u * 1024u;
               asm volatile("" : "+v"(o0), "+v"(o1), "+v"(o2), "+v"(o3)); }
    }
};
}

#define XB_TMO      128
#define XB_XCNT(j)  (256  + 64 * (j))
#define XB_XSUB(j)  (1280 + 64 * (j))
#define XB_XGEN(j)  (2304 + 64 * (j))
#define XB_TOP      3328
#define XB_TOPGEN   3392
#define XCD_BAR_WORDS 3456
#define XB_SPIN_CAP (1u << 18)
__device__ __forceinline__ unsigned xb_ld(unsigned* p)              { return __hip_atomic_load(p, __ATOMIC_RELAXED, __HIP_MEMORY_SCOPE_AGENT); }
__device__ __forceinline__ unsigned xb_add(unsigned* p, unsigned v) { return __hip_atomic_fetch_add(p, v, __ATOMIC_RELAXED, __HIP_MEMORY_SCOPE_AGENT); }
__device__ __forceinline__ unsigned xb_xcc_id() { return (unsigned)__builtin_amdgcn_s_getreg((3 << 11) | 20) & 0xFu; }
#define XB_SPIN(cond, bar) do { unsigned _sp = 0; while (cond) { __builtin_amdgcn_s_sleep(1); \
    if ((++_sp & 255u) == 0u) { if (xb_ld(&(bar)[XB_TMO])) break; if (_sp > XB_SPIN_CAP) { atomicAdd(&(bar)[XB_TMO], 1u); break; } } } } while (0)
struct XcdBarrier { unsigned* bar; unsigned x; volatile LAS unsigned* st; };
__device__ __forceinline__ XcdBarrier xcd_barrier_post(unsigned* bar, volatile LAS unsigned* st) {
    XcdBarrier b; b.bar = bar; b.x = xb_xcc_id(); b.st = st;
    if (threadIdx.x == 0) (void)xb_add(&bar[XB_XCNT(b.x)], 1u);
    return b;
}
__device__ __forceinline__ void xcd_barrier_complete(unsigned* bar, unsigned x, unsigned& nloc, unsigned& nx) {
    const unsigned G = gridDim.x * gridDim.y * gridDim.z;
    unsigned sum, cnt, mine, sp = 0u;
    for (;;) {
        sum = 0u; cnt = 0u; mine = 0u;
#pragma unroll
        for (unsigned j = 0; j < 16; ++j) { const unsigned c = xb_ld(&bar[XB_XCNT(j)]); sum += c; cnt += (c > 0u) ? 1u : 0u; mine = (j == x) ? c : mine; }
        if (sum == G) break;
        __builtin_amdgcn_s_sleep(1);
        if ((++sp & 255u) == 0u) { if (xb_ld(&bar[XB_TMO])) break; if (sp > XB_SPIN_CAP) { atomicAdd(&bar[XB_TMO], 1u); break; } }
    }
    nloc = mine > 0u ? mine : 1u; nx = cnt > 0u ? cnt : 1u;
}
__device__ __forceinline__ void xcd_barrier(const XcdBarrier& b) {
    asm volatile("s_waitcnt vmcnt(0)" ::: "memory");
    __syncthreads();
    if (threadIdx.x == 0) {
        unsigned* bar = b.bar;
        __builtin_amdgcn_s_waitcnt(0);
        unsigned nloc = b.st[0], nx = b.st[1];
        if (nloc == 0u) { xcd_barrier_complete(bar, b.x, nloc, nx); b.st[0] = nloc; b.st[1] = nx; }
        const unsigned old = xb_add(&bar[XB_XSUB(b.x)], 1u);
        const unsigned gen = old / nloc;
        if (old + 1u == (gen + 1u) * nloc) {
            __builtin_amdgcn_fence(__ATOMIC_RELEASE, "agent");
            asm volatile("s_waitcnt vmcnt(0)" ::: "memory");
            const unsigned og = xb_add(&bar[XB_TOP], 1u);
            const unsigned tg = og / nx;
            if (og + 1u == (tg + 1u) * nx) xb_add(&bar[XB_TOPGEN], 1u);
            else XB_SPIN(xb_ld(&bar[XB_TOPGEN]) == tg, bar);
            __builtin_amdgcn_fence(__ATOMIC_ACQUIRE, "agent");
            xb_add(&bar[XB_XGEN(b.x)], 1u);
            asm volatile("s_waitcnt vmcnt(0)" ::: "memory");
        } else {
            XB_SPIN(xb_ld(&bar[XB_XGEN(b.x)]) == gen, bar);
            __builtin_amdgcn_fence(__ATOMIC_ACQUIRE, "agent");
            asm volatile("s_waitcnt vmcnt(0)" ::: "memory");
        }
    }
    __syncthreads();
}

constexpr int NWAVES = 8, NTHREADS = 512;
struct Args { const float* in[29]; float* out; unsigned char* ws; int ph_lo, ph_hi, li, dbg; };
enum { I_X = 0, I_NMG, I_WIN, I_CONVW, I_CONVB, I_WRGA, I_BRGA, I_WRGX, I_BRGX, I_LAMBDA, I_DLQ1, I_DLK1, I_DLQ2, I_DLK2, I_SUBG, I_REL, I_WPRNN, I_WPATT, I_WOUT, I_NFG, I_WROUTER, I_BROUTER,
       I_WGATE, I_BGATE, I_WUP, I_BUP, I_WDOWN, I_BDOWN, I_NFINAL };

__device__ __forceinline__ void p0_transpose_item(const float* W, int K, int N, bf16_t* WT, int row_off, LAS float* scr, int item, int lane) {
    const int nblk = N / 32, kb = item / nblk, nb = item % nblk, k0 = 64 * kb, n0 = 32 * nb;
#pragma unroll 8
    for (int i = 0; i < 32; ++i) { const int kk = 2 * i + (lane >> 5); scr[kk * 33 + (lane & 31)] = W[(size_t)(k0 + kk) * N + n0 + (lane & 31)]; }
    LDS_WAIT(); asm volatile("" ::: "memory");
    const int c = lane & 7;
#pragma unroll
    for (int j = 0; j < 4; ++j) { const int n = (lane >> 3) + 8 * j; const LAS float* s = scr + (8 * c) * 33 + n;
        u32x4 o; o.x = cvtpk(s[0 * 33], s[1 * 33]); o.y = cvtpk(s[2 * 33], s[3 * 33]); o.z = cvtpk(s[4 * 33], s[5 * 33]); o.w = cvtpk(s[6 * 33], s[7 * 33]);
        *(u32x4*)((char*)WT + pg8::btile_off(row_off + n0 + n, (k0 + 8 * c) * 2, K / 64)) = o; }
    LDS_WAIT(); asm volatile("" ::: "memory");
}
__device__ __forceinline__ void p0_transpose_item_fp8(const float* W, int K, int N, unsigned char* WT, int row_off, LAS float* scr, int item, int lane, float scale) {
    const int nblk = N / 32, kb = item / nblk, nb = item % nblk, k0 = 64 * kb, n0 = 32 * nb;
    float wv_[32];
#pragma unroll
    for (int i = 0; i < 32; ++i) { const int kk = 2 * i + (lane >> 5); wv_[i] = W[(size_t)(k0 + kk) * N + n0 + (lane & 31)]; }
#pragma unroll
    for (int i = 0; i < 32; ++i) { const int kk = 2 * i + (lane >> 5); scr[kk * 33 + (lane & 31)] = wv_[i] * scale; }
    LDS_WAIT(); asm volatile("" ::: "memory");
    const int c = lane & 7;
#pragma unroll
    for (int j = 0; j < 4; ++j) { const int n = (lane >> 3) + 8 * j; const LAS float* s = scr + (8 * c) * 33 + n;
        u32x2 o; o.x = cvt4_fp8(s[0 * 33], s[1 * 33], s[2 * 33], s[3 * 33]); o.y = cvt4_fp8(s[4 * 33], s[5 * 33], s[6 * 33], s[7 * 33]);
        *(u32x2*)(WT + pg8::btile_off(row_off + n0 + n, k0 + 8 * c, K / 128)) = o; }
    LDS_WAIT(); asm volatile("" ::: "memory");
}
__device__ __forceinline__ void rms_row_to_bf16(const float* xrow, bf16_t* orow, const f32x4 (&g)[4], int lane) {
    const f32x4* xr = (const f32x4*)xrow + lane;
    f32x4 v[4]; float s = 0.f;
#pragma unroll
    for (int j = 0; j < 4; ++j) { v[j] = xr[64 * j]; s += (v[j].x * v[j].x + v[j].y * v[j].y) + (v[j].z * v[j].z + v[j].w * v[j].w); }
    const float rstd = 1.0f / sqrtf(wave_sum(s) * (1.f / D) + EPS);
    u32x2* o8 = (u32x2*)orow + lane;
#pragma unroll
    for (int j = 0; j < 4; ++j) { const f32x4 y = v[j] * rstd * g[j]; u32x2 w; w.x = cvtpk(y.x, y.y); w.y = cvtpk(y.z, y.w); o8[64 * j] = w; }
}
__device__ __forceinline__ int rel_bucket_dev(int n) {
    if (n < 16) return n;
    const float v = logf((float)n / 16.0f) / logf(8.0f) * 16.0f; int b = 16 + (int)v; return b < 31 ? b : 31;
}

#define LB() asm volatile("s_waitcnt lgkmcnt(0)\n\ts_barrier" ::: "memory")
namespace rglru {
constexpr int TL = 128, PITCH = 144;
constexpr int WV = 9728;
constexpr int W_XR = 0, W_GR = 2816, W_XC = 5120;
constexpr int L_AGG = 8 * WV  , L_CW = L_AGG + 8192  , L_WF = L_CW + 1536  ;
struct Tensors { const bf16_t* xr; const bf16_t* gr; bf16_t* y; const float* conv_w; const float* conv_b; const float* w_a; const float* b_a; const float* w_x; const float* b_x; const float* sp; };

__device__ __forceinline__ void unit(LAS unsigned char* lds, const Tensors& P, int b, int n) {
    const int tid = threadIdx.x, lane = tid & 63, wid = __builtin_amdgcn_readfirstlane(tid >> 6), l16 = lane & 15, q4 = lane >> 4;
    LAS unsigned char* wl = lds + wid * WV;
    LB();
    if (tid < 320) { const int j = tid >> 6, c = tid & 63; ((LAS float*)(lds + L_CW))[tid] = (j < 4) ? P.conv_w[j * D + n * 64 + c] : P.conv_b[n * 64 + c]; }
#pragma unroll 1
    for (int f = wid; f < 16; f += 8) { const int g = f >> 3, db = (f >> 1) & 3, ks = f & 1; const float* W = (g == 0 ? P.w_a : P.w_x) + (size_t)n * 64 * 64; float v[8];
#pragma unroll
        for (int j = 0; j < 8; ++j) v[j] = W[(32 * ks + 8 * q4 + j) * 64 + 16 * db + l16];
        u32x4 w; w.x = cvtpk(v[0], v[1]); w.y = cvtpk(v[2], v[3]); w.z = cvtpk(v[4], v[5]); w.w = cvtpk(v[6], v[7]); *(LAS u32x4*)(lds + L_WF + (f * 64 + lane) * 16) = w; }
    const int sh16 = ((lane - 16) & 63) * 4, sh32 = ((lane - 32) & 63) * 4;
#define RG_UP(v, sh) __int_as_float(__builtin_amdgcn_ds_bpermute(sh, __float_as_int(v)))
    float ba[4], bx[4], sp[4], hin[4];
#pragma unroll
    for (int db = 0; db < 4; ++db) { const int d = n * 64 + 16 * db + l16; ba[db] = P.b_a[d]; bx[db] = P.b_x[d]; sp[db] = P.sp[d] * (-8.0f * LOG2E); hin[db] = 0.f; }
    const size_t rowb = (size_t)b * SEQ;
    const bf16_t* xg = P.xr + n * 64; const bf16_t* gg = P.gr + n * 64; bf16_t* yg = P.y + n * 64;
    u32x4 pxr[3], pgr[2];
    const u32x4 z4 = {0u, 0u, 0u, 0u};
#define RG_LOAD(t0) do { const int tb_ = (t0) + 16 * wid; \
        _Pragma("unroll") for (int i = 0; i < 3; ++i) { const int cid = lane + 64 * i, row = cid >> 3, ch = cid & 7, tm = tb_ - 3 + row; \
            pxr[i] = (cid < 152 && tm >= 0) ? *(const u32x4*)(xg + (rowb + tm) * D + ch * 8) : z4; } \
        _Pragma("unroll") for (int i = 0; i < 2; ++i) { const int cid = lane + 64 * i, row = cid >> 3, ch = cid & 7; \
            pgr[i] = *(const u32x4*)(gg + (rowb + tb_ + row) * D + ch * 8); } } while (0)
    RG_LOAD(0);
    LB();
    for (int tile = 0; tile < SEQ / TL; ++tile) {
        const int t0 = tile * TL;
#pragma unroll
        for (int i = 0; i < 3; ++i) { const int cid = lane + 64 * i, row = cid >> 3, ch = cid & 7; if (cid < 152) *(LAS u32x4*)(wl + W_XR + row * PITCH + ch * 16) = pxr[i]; }
#pragma unroll
        for (int i = 0; i < 2; ++i) { const int cid = lane + 64 * i, row = cid >> 3, ch = cid & 7; *(LAS u32x4*)(wl + W_GR + row * PITCH + ch * 16) = pgr[i]; }
        LDS_WAIT();
        if (tile + 1 < SEQ / TL) RG_LOAD(t0 + TL);
        bf16x8 af[2];
#pragma unroll
        for (int ks = 0; ks < 2; ++ks) { const int c0 = 32 * ks + 8 * q4;
            const LAS float* cw = (const LAS float*)(lds + L_CW);
            f32x4 s0 = *(const LAS f32x4*)(cw + 256 + c0), s1 = *(const LAS f32x4*)(cw + 256 + c0 + 4);
#pragma unroll
            for (int jj = 0; jj < 4; ++jj) { const u32x4 xv = *(const LAS u32x4*)(wl + W_XR + (l16 + jj) * PITCH + c0 * 2);
                const f32x4 w0 = *(const LAS f32x4*)(cw + jj * 64 + c0), w1 = *(const LAS f32x4*)(cw + jj * 64 + c0 + 4);
                s0 += w0 * (f32x4){bflo(xv.x), bfhi(xv.x), bflo(xv.y), bfhi(xv.y)}; s1 += w1 * (f32x4){bflo(xv.z), bfhi(xv.z), bflo(xv.w), bfhi(xv.w)}; }
            *(LAS f32x4*)(wl + W_XC + (l16 * 68 + c0) * 4) = s0; *(LAS f32x4*)(wl + W_XC + (l16 * 68 + c0 + 4) * 4) = s1;
            u32x4 w; w.x = cvtpk(s0[0], s0[1]); w.y = cvtpk(s0[2], s0[3]); w.z = cvtpk(s1[0], s1[1]); w.w = cvtpk(s1[2], s1[3]); af[ks] = __builtin_bit_cast(bf16x8, w); }
        f32x4 ra[4], rx[4];
#pragma unroll
        for (int db = 0; db < 4; ++db) { ra[db] = (f32x4){0.f, 0.f, 0.f, 0.f}; rx[db] = ra[db];
#pragma unroll
            for (int ks = 0; ks < 2; ++ks) { const bf16x8 wa = *(const LAS bf16x8*)(lds + L_WF + (((0 * 4 + db) * 2 + ks) * 64 + lane) * 16), wx = *(const LAS bf16x8*)(lds + L_WF + (((1 * 4 + db) * 2 + ks) * 64 + lane) * 16);
                ra[db] = __builtin_amdgcn_mfma_f32_16x16x32_bf16(af[ks], wa, ra[db], 0, 0, 0); rx[db] = __builtin_amdgcn_mfma_f32_16x16x32_bf16(af[ks], wx, rx[db], 0, 0, 0); } }
        LDS_WAIT();
        float av[4][4], uv[4][4], gl[4][4], EA[4], EH[4];
        const int tc = 4 * q4;
        LAS unsigned char* agg = lds + L_AGG + (tile & 1) * 4096;
#pragma unroll
        for (int db = 0; db < 4; ++db) { const int d = 16 * db + l16;
#pragma unroll
            for (int j = 0; j < 4; ++j) {
                const float xc = *(const LAS float*)(wl + W_XC + ((tc + j) * 68 + d) * 4);
                const float g = bf2f(*(const LAS unsigned short*)(wl + W_GR + (tc + j) * PITCH + d * 2));
                const float r = sigmoidf_(ra[db][j] + ba[db]), ig = sigmoidf_(rx[db][j] + bx[db]);
                const float a = fast_exp2(r * sp[db]);
                av[db][j] = a; uv[db][j] = __builtin_amdgcn_sqrtf(fmaxf(1.0f - a * a, 0.f)) * (ig * xc);
                gl[db][j] = g * fast_rcp(1.0f + fast_exp2(g * ((-2.0f * 0.7978845608028654f * LOG2E) + (-2.0f * 0.7978845608028654f * LOG2E * 0.044715f) * (g * g))));
            }
            float a_ = av[db][0] * av[db][1] * av[db][2] * av[db][3];
            float h_ = ((uv[db][0] * av[db][1] + uv[db][1]) * av[db][2] + uv[db][2]) * av[db][3] + uv[db][3];
            float pa = RG_UP(a_, sh16), ph = RG_UP(h_, sh16);
            if (q4 >= 1) { h_ = ph * a_ + h_; a_ = pa * a_; }
            pa = RG_UP(a_, sh32); ph = RG_UP(h_, sh32);
            if (q4 >= 2) { h_ = ph * a_ + h_; a_ = pa * a_; }
            EA[db] = RG_UP(a_, sh16); EH[db] = RG_UP(h_, sh16);
            if (q4 == 3) { *(LAS f32x2*)(agg + ((wid * 64 + d) * 2) * 4) = (f32x2){a_, h_}; }
        }
        LB();
#pragma unroll
        for (int db = 0; db < 4; ++db) { const int d = 16 * db + l16;
            float hw = hin[db], hall = hin[db];
#pragma unroll
            for (int w2 = 0; w2 < 8; ++w2) { const f32x2 ag = *(const LAS f32x2*)(agg + ((w2 * 64 + d) * 2) * 4); hall = ag.x * hall + ag.y; if (w2 < wid) hw = hall; }
            hin[db] = hall;
            float h = (q4 == 0) ? hw : (EA[db] * hw + EH[db]);
#pragma unroll
            for (int j = 0; j < 4; ++j) { h = av[db][j] * h + uv[db][j];
                const unsigned yb = cvtpk(h * gl[db][j], 0.f);
                *(LAS unsigned short*)(wl + W_GR + (tc + j) * PITCH + d * 2) = (unsigned short)(yb & 0xffffu); }
        }
        LDS_WAIT();
#pragma unroll
        for (int i = 0; i < 2; ++i) { const int cid = lane + 64 * i, row = cid >> 3, ch = cid & 7;
            *(u32x4*)(yg + (rowb + t0 + 16 * wid + row) * D + ch * 8) = *(const LAS u32x4*)(wl + W_GR + row * PITCH + ch * 16); }
        LDS_WAIT();
    }
#undef RG_LOAD
#undef RG_UP
    LB();
}
}

namespace att {
constexpr int STG = 32768;
constexpr int NSTG = 4;
constexpr int L_WS = LDSCTL_OFF + 1024  , L_BT = LDSCTL_OFF + 3072  , L_OS = 65536  , L_X = 0  ;
constexpr int OSP = 272;
constexpr float THR = 8.0f;
struct Tensors { const bf16_t* Q; const bf16_t* K; const bf16_t* V; bf16_t* Y; const float* bt; const float* subg; const float* lam; const float* km2; const float* bmax; };
__device__ __forceinline__ int crow(int r, int hi) { return (r & 3) + 8 * (r >> 2) + 4 * hi; }
typedef short v4i16_t __attribute__((ext_vector_type(4)));
#define VTR_ISSUE(dst, p, off) asm volatile("ds_read_b64_tr_b16 %0, %1 offset:%2" : "=v"(dst) : "v"(p), "i"(off))
#define VFR_ISSUE(j, vp_) do { VTR_ISSUE(vl_[j], vp_, ((j) & 3) * 4096 + ((j) >> 2) * 1024); VTR_ISSUE(vh_[j], vp_, ((j) & 3) * 4096 + ((j) >> 2) * 1024 + 512); } while (0)
#define VFR_WAITN(n, j) asm volatile("s_waitcnt lgkmcnt(" #n ")" : "+v"(vl_[j]), "+v"(vh_[j]))
#define VFR_WAIT(j) do { if ((j) <= 11) VFR_WAITN(8, j); else if ((j) == 12) VFR_WAITN(6, j); else if ((j) == 13) VFR_WAITN(4, j); else if ((j) == 14) VFR_WAITN(2, j); else VFR_WAITN(0, j); } while (0)
#define VFR_GET(j) ((bf16x8){vl_[j][0], vl_[j][1], vl_[j][2], vl_[j][3], vh_[j][0], vh_[j][1], vh_[j][2], vh_[j][3]})
__device__ __forceinline__ float max3f(float a, float b, float c) { return __builtin_fmaxf(__builtin_fmaxf(a, b), c); }
__device__ __forceinline__ float swapmax(float m) { auto rr = __builtin_amdgcn_permlane32_swap(__float_as_uint(m), __float_as_uint(m), false, false); return fmaxf(__uint_as_float(rr[0]), __uint_as_float(rr[1])); }
__device__ __forceinline__ float swapsum(float m) { auto rr = __builtin_amdgcn_permlane32_swap(__float_as_uint(m), __float_as_uint(m), false, false); return __uint_as_float(rr[0]) + __uint_as_float(rr[1]); }

#define ATT_PK(P, B) cvtpk(P[B], P[(B) + 1])
template <class QP> __device__ __forceinline__ void unit(LAS unsigned char* lds, const Tensors& P, int& item, int& rot, bool& pre, unsigned& popv, float& btp, float& kmp, float& bmp, bf16x8 (&qr)[4], const int qlo, const int qhi, QP qctr) {
    const int tid = threadIdx.x, lane = tid & 63, r32 = lane & 31, hi = lane >> 5, wid = __builtin_amdgcn_readfirstlane(tid >> 6), map = wid >> 2, qs = wid & 3;
    const int j_ = item - 128, qb = 31 - (j_ >> 6), b = (j_ & 63) >> 3, h = j_ & 7;
    LAS unsigned* lwq = (LAS unsigned*)(lds + LDSCTL_OFF) + LW_Q;
#define STGOF(t) ((((t) + rot) & 3) * STG)
    const size_t rowb = (size_t)b * SEQ; const int q0 = qb * 128, qw0 = q0 + 32 * qs, NTL = 2 * qb + 2;
    LAS float* wsf = (LAS float*)(lds + L_WS) + wid * 64;
    if (tid < 128) ((LAS float*)(lds + L_BT))[tid] = pre ? btp : P.bt[h * 128 + tid] - P.bt[h * 128 + 127];
    const bf16_t* ks1 = P.K + ((size_t)((b * 8 + h) * 2) * 64) * 4096 + wid * 512 + lane * 8;
    const bf16_t* ks2 = ks1 + (size_t)64 * 4096;
    const bf16_t* vsa = P.V + ((size_t)(b * 8 + h) * 64) * 8192 + wid * 512 + lane * 8;
    const bf16_t* vsb = vsa + 8 * 512;
    const int dk1 = wid * 1024, dk2 = 8192 + wid * 1024, dva = 16384 + wid * 1024, dvb = 16384 + (wid + 8) * 1024;
#define ATT_DMA(t, st) do { const size_t gk = (size_t)(t) * 4096, gv = (size_t)(t) * 8192; \
        __builtin_amdgcn_global_load_lds((const GAS unsigned*)(ks1 + gk), (LAS unsigned*)(lds + (st) + dk1), 16, 0, 0); \
        __builtin_amdgcn_global_load_lds((const GAS unsigned*)(ks2 + gk), (LAS unsigned*)(lds + (st) + dk2), 16, 0, 0); \
        __builtin_amdgcn_global_load_lds((const GAS unsigned*)(vsa + gv), (LAS unsigned*)(lds + (st) + dva), 16, 0, 0); \
        __builtin_amdgcn_global_load_lds((const GAS unsigned*)(vsb + gv), (LAS unsigned*)(lds + (st) + dvb), 16, 0, 0); } while (0)
    if (!pre) {
        ATT_DMA(0, STGOF(0));
        ATT_DMA(1, STGOF(1));
#pragma unroll
        for (int d0 = 0; d0 < 4; ++d0) qr[d0] = *(const bf16x8*)(P.Q + (rowb + qw0 + r32) * D + h * 128 + map * 64 + d0 * 16 + hi * 8);
    }
    float mref = 0.f, lsum = 0.f;
    f32x16 o[4]; const f32x16 zero16 = {0.f, 0.f, 0.f, 0.f, 0.f, 0.f, 0.f, 0.f, 0.f, 0.f, 0.f, 0.f, 0.f, 0.f, 0.f, 0.f};
#pragma unroll
    for (int r = 0; r < 16; ++r) { o[0][r] = 0.f; o[1][r] = 0.f; o[2][r] = 0.f; o[3][r] = 0.f; }
    const LAS unsigned char* kb0 = lds + map * 8192 + hi * 1024 + r32 * 16;
    const LAS unsigned char* vp0 = lds + 16384 + ((lane >> 4) & 1) * 32 + (lane & 3) * 8 + (4 * hi + ((lane & 15) >> 2)) * 64;
    const LAS float* btl = (const LAS float*)(lds + L_BT);
    f32x16 pA0, pA1, pB0, pB1; u32x4 pw0, pw1, pw2, pw3; bool resc = false;
#define KFR(kb_, i) (*(const LAS bf16x8*)((kb_) + ((i) >> 1) * 2048 + ((i) & 1) * 512))
#define ATT_DECIDE(C0, C1, t, FAST) do { const int k0_ = 64 * (t); \
        if (!(FAST) && __any(mref != 0.f)) { _Pragma("unroll") for (int r = 0; r < 16; ++r) { C0[r] -= mref; C1[r] -= mref; } } \
        if ((qw0 - (k0_ + 63)) < 113) { const int base_ = qw0 + r32 - k0_ - 4 * hi; \
            _Pragma("unroll") for (int r = 0; r < 16; ++r) { const int d0_ = base_ - ((r & 3) + 8 * (r >> 2)), d1_ = d0_ - 32; \
                const float b0_ = btl[min(max(d0_, 0), 127)], b1_ = btl[min(max(d1_, 0), 127)]; \
                C0[r] = (d0_ < 0) ? -INFINITY : C0[r] + b0_; C1[r] = (d1_ < 0) ? -INFINITY : C1[r] + b1_; if ((r & 3) == 3) SBAR(); } } \
        if (!(FAST)) { \
        float rm_ = max3f(C0[0], C0[1], C1[0]), rn_ = max3f(C0[2], C0[3], C1[1]); rm_ = max3f(rm_, C1[2], C1[3]); \
        _Pragma("unroll") for (int r = 4; r < 16; r += 4) { rm_ = max3f(rm_, C0[r], C0[r + 1]); rn_ = max3f(rn_, C0[r + 2], C0[r + 3]); rm_ = max3f(rm_, C1[r], C1[r + 1]); rn_ = max3f(rn_, C1[r + 2], C1[r + 3]); } \
        rm_ = swapmax(max3f(rm_, rn_, rn_)); \
        const bool first_ = ((t) == 0);                                    \
        resc = __any(rm_ > THR || (first_ && rm_ < -THR)); \
        if (resc) { const float dl_ = first_ ? rm_ : fmaxf(rm_, 0.f); mref += dl_; \
            _Pragma("unroll") for (int r = 0; r < 16; ++r) { C0[r] -= dl_; C1[r] -= dl_; } \
            const float f_ = first_ ? 1.0f : fast_exp2(-dl_); lsum *= f_; if (hi == 0) wsf[r32] = f_; } } } while (0)
#define ATT_RESC(FAST) do { if (!(FAST) && resc) { LDS_WAIT(); \
        _Pragma("unroll") for (int r = 0; r < 16; ++r) { const float f_ = wsf[crow(r, hi)]; o[0][r] *= f_; o[1][r] *= f_; o[2][r] *= f_; o[3][r] *= f_; } } } while (0)
#define ATT_GA(CX, KF, D0, FIRST, a0, a1, a2, a3, PWX, PSRC, PB0) do { \
        CX = __builtin_amdgcn_mfma_f32_32x32x16_bf16(KF, qr[D0], (FIRST) ? negm : CX, 0, 0, 0); \
        sacc += (a0 + a1) + (a2 + a3); PWX = ATT_PK(PSRC, PB0); } while (0)
#define ATT_STEP(C0, C1, P0, P1, t, FAST) do { \
        const LAS unsigned char* kb_ = kb0 + STGOF(t); const LAS unsigned char* vp_ = vp0 + STGOF((t) + 3); \
        bf16x8 ka_ = KFR(kb_, 0), kc_ = KFR(kb_, 1); float sacc = 0.f; s16x4 vl_[16], vh_[16]; \
        SBAR(); \
        C0 = __builtin_amdgcn_mfma_f32_32x32x16_bf16(ka_, qr[0], zero16, 0, 0, 0); ka_ = KFR(kb_, 2); sacc += (P0[0] + P0[1]) + (P0[2] + P0[3]); pw0.x = ATT_PK(P0, 0); pw0.y = ATT_PK(P0, 2); asm volatile("" : "+v"(sacc)); asm volatile("" : "+v"(pw0)); SBAR(); \
        C1 = __builtin_amdgcn_mfma_f32_32x32x16_bf16(kc_, qr[0], zero16, 0, 0, 0); kc_ = KFR(kb_, 3); sacc += (P0[4] + P0[5]) + (P0[6] + P0[7]); pw0.z = ATT_PK(P0, 4); pw0.w = ATT_PK(P0, 6); asm volatile("" : "+v"(sacc)); asm volatile("" : "+v"(pw0)); SBAR(); \
        C0 = __builtin_amdgcn_mfma_f32_32x32x16_bf16(ka_, qr[1], C0, 0, 0, 0); ka_ = KFR(kb_, 4); sacc += (P0[8] + P0[9]) + (P0[10] + P0[11]); pw1.x = ATT_PK(P0, 8); pw1.y = ATT_PK(P0, 10); asm volatile("" : "+v"(sacc)); asm volatile("" : "+v"(pw1)); SBAR(); \
        C1 = __builtin_amdgcn_mfma_f32_32x32x16_bf16(kc_, qr[1], C1, 0, 0, 0); kc_ = KFR(kb_, 5); sacc += (P0[12] + P0[13]) + (P0[14] + P0[15]); pw1.z = ATT_PK(P0, 12); pw1.w = ATT_PK(P0, 14); asm volatile("" : "+v"(sacc)); asm volatile("" : "+v"(pw1)); SBAR(); \
        C0 = __builtin_amdgcn_mfma_f32_32x32x16_bf16(ka_, qr[2], C0, 0, 0, 0); ka_ = KFR(kb_, 6); sacc += (P1[0] + P1[1]) + (P1[2] + P1[3]); pw2.x = ATT_PK(P1, 0); pw2.y = ATT_PK(P1, 2); asm volatile("" : "+v"(sacc)); asm volatile("" : "+v"(pw2)); SBAR(); \
        C1 = __builtin_amdgcn_mfma_f32_32x32x16_bf16(kc_, qr[2], C1, 0, 0, 0); kc_ = KFR(kb_, 7); sacc += (P1[4] + P1[5]) + (P1[6] + P1[7]); pw2.z = ATT_PK(P1, 4); pw2.w = ATT_PK(P1, 6); asm volatile("" : "+v"(sacc)); asm volatile("" : "+v"(pw2)); SBAR(); \
        C0 = __builtin_amdgcn_mfma_f32_32x32x16_bf16(ka_, qr[3], C0, 0, 0, 0); VFR_ISSUE(0, vp_); VFR_ISSUE(1, vp_); sacc += (P1[8] + P1[9]) + (P1[10] + P1[11]); pw3.x = ATT_PK(P1, 8); pw3.y = ATT_PK(P1, 10); asm volatile("" : "+v"(sacc)); asm volatile("" : "+v"(pw3)); SBAR(); \
        C1 = __builtin_amdgcn_mfma_f32_32x32x16_bf16(kc_, qr[3], C1, 0, 0, 0); VFR_ISSUE(2, vp_); VFR_ISSUE(3, vp_); sacc += (P1[12] + P1[13]) + (P1[14] + P1[15]); pw3.z = ATT_PK(P1, 12); pw3.w = ATT_PK(P1, 14); asm volatile("" : "+v"(sacc)); asm volatile("" : "+v"(pw3)); SBAR(); \
        lsum += sacc; \
        ATT_DECIDE(C0, C1, t, FAST); SBAR(); \
        _Pragma("unroll") for (int j = 0; j < 16; ++j) { \
            if (j + 4 < 16) VFR_ISSUE(j + 4, vp_); \
            VFR_WAIT(j); \
            const u32x4 pwj_ = (j >> 2) == 0 ? pw0 : (j >> 2) == 1 ? pw1 : (j >> 2) == 2 ? pw2 : pw3; \
            o[j & 3] = __builtin_amdgcn_mfma_f32_32x32x16_bf16(__builtin_bit_cast(bf16x8, pwj_), VFR_GET(j), o[j & 3], 0, 0, 0); \
            if (j < 8) { C0[2 * j] = fast_exp2(C0[2 * j]); C0[2 * j + 1] = fast_exp2(C0[2 * j + 1]); asm volatile("" : "+v"(C0)); } else { C1[2 * j - 16] = fast_exp2(C1[2 * j - 16]); C1[2 * j - 15] = fast_exp2(C1[2 * j - 15]); asm volatile("" : "+v"(C1)); } \
            SBAR(); } \
        ATT_RESC(FAST); } while (0)
#define ATT_TOP(t) do { if ((t) + 1 < NTL) asm volatile("s_waitcnt vmcnt(4) lgkmcnt(0)\n\ts_barrier" ::: "memory"); else WG_BAR(); \
        if ((t) == 0 && pre && tid == 0) lwq[0] = popv;                      \
        if ((t) + 2 < NTL) ATT_DMA((t) + 2, STGOF((t) + 2)); } while (0)
#define ATT_DRAIN(P0, P1, vp_) do { float sacc = 0.f; \
        _Pragma("unroll") for (int r = 0; r < 16; ++r) sacc += P0[r] + P1[r]; \
        lsum += sacc; \
        pw0 = (u32x4){ATT_PK(P0, 0), ATT_PK(P0, 2), ATT_PK(P0, 4), ATT_PK(P0, 6)}; pw1 = (u32x4){ATT_PK(P0, 8), ATT_PK(P0, 10), ATT_PK(P0, 12), ATT_PK(P0, 14)}; \
        pw2 = (u32x4){ATT_PK(P1, 0), ATT_PK(P1, 2), ATT_PK(P1, 4), ATT_PK(P1, 6)}; pw3 = (u32x4){ATT_PK(P1, 8), ATT_PK(P1, 10), ATT_PK(P1, 12), ATT_PK(P1, 14)}; \
        s16x4 vl_[16], vh_[16]; VFR_ISSUE(0, vp_); VFR_ISSUE(1, vp_); VFR_ISSUE(2, vp_); VFR_ISSUE(3, vp_); \
        _Pragma("unroll") for (int j = 0; j < 16; ++j) { if (j + 4 < 16) VFR_ISSUE(j + 4, vp_); \
            VFR_WAIT(j); \
            const u32x4 pwj_ = (j >> 2) == 0 ? pw0 : (j >> 2) == 1 ? pw1 : (j >> 2) == 2 ? pw2 : pw3; \
            o[j & 3] = __builtin_amdgcn_mfma_f32_32x32x16_bf16(__builtin_bit_cast(bf16x8, pwj_), VFR_GET(j), o[j & 3], 0, 0, 0); } } while (0)
    bool fast;
    {   float qn = 0.f;
#pragma unroll
        for (int d0 = 0; d0 < 4; ++d0) { const u32x4 w = __builtin_bit_cast(u32x4, qr[d0]); const float a0 = bflo(w.x), a1 = bfhi(w.x), a2 = bflo(w.y), a3 = bfhi(w.y), a4 = bflo(w.z), a5 = bfhi(w.z), a6 = bflo(w.w), a7 = bfhi(w.w);
            qn += (a0 * a0 + a1 * a1) + (a2 * a2 + a3 * a3) + (a4 * a4 + a5 * a5) + (a6 * a6 + a7 * a7); }
        qn = swapsum(qn);
        const float km2 = (pre ? kmp : P.km2[((b * 8 + h) * 2 + map) * 2] + P.km2[((b * 8 + h) * 2 + map) * 2 + 1]) * 1.05f;
        const float bound = sqrtf(qn * km2) + (pre ? bmp : P.bmax[h]);
        fast = !__any(!(bound < 96.0f));
    }
#define ATT_WALK(FAST) do { \
    ATT_TOP(0); \
    { const LAS unsigned char* kbf_ = kb0 + STGOF(0); _Pragma("unroll") for (int d0 = 0; d0 < 4; ++d0) { const bf16x8 k0_ = KFR(kbf_, 2 * d0), k1_ = KFR(kbf_, 2 * d0 + 1); \
            pA0 = __builtin_amdgcn_mfma_f32_32x32x16_bf16(k0_, qr[d0], d0 == 0 ? zero16 : pA0, 0, 0, 0); pA1 = __builtin_amdgcn_mfma_f32_32x32x16_bf16(k1_, qr[d0], d0 == 0 ? zero16 : pA1, 0, 0, 0); } \
        ATT_DECIDE(pA0, pA1, 0, FAST); \
        _Pragma("unroll") for (int r = 0; r < 16; ++r) { pA0[r] = fast_exp2(pA0[r]); pA1[r] = fast_exp2(pA1[r]); } \
        ATT_RESC(FAST); } \
    int t = 1; \
    _Pragma("unroll 1") for (; t + 1 < NTL; t += 2) { \
        ATT_TOP(t); ATT_STEP(pB0, pB1, pA0, pA1, t, FAST); \
        ATT_TOP(t + 1); ATT_STEP(pA0, pA1, pB0, pB1, t + 1, FAST); } \
    ATT_TOP(t); ATT_STEP(pB0, pB1, pA0, pA1, t, FAST); \
    { const LAS unsigned char* vpl = vp0 + STGOF(NTL - 1); ATT_DRAIN(pB0, pB1, vpl); } } while (0)
    if (fast) ATT_WALK(1);
    else {
#pragma unroll 1
        for (int t = 0; t < NTL; ++t) {
            ATT_TOP(t);
            const LAS unsigned char* kb_ = kb0 + STGOF(t); const LAS unsigned char* vp_ = vp0 + STGOF(t);
#pragma unroll
            for (int d0 = 0; d0 < 4; ++d0) { const bf16x8 k0_ = KFR(kb_, 2 * d0), k1_ = KFR(kb_, 2 * d0 + 1);
                pA0 = __builtin_amdgcn_mfma_f32_32x32x16_bf16(k0_, qr[d0], d0 == 0 ? zero16 : pA0, 0, 0, 0); pA1 = __builtin_amdgcn_mfma_f32_32x32x16_bf16(k1_, qr[d0], d0 == 0 ? zero16 : pA1, 0, 0, 0); }
            ATT_DECIDE(pA0, pA1, t, 0);
            ATT_RESC(0);
            float sacc = 0.f;
#pragma unroll
            for (int r = 0; r < 16; ++r) { pA0[r] = fast_exp2(pA0[r]); pA1[r] = fast_exp2(pA1[r]); sacc += pA0[r] + pA1[r]; }
            lsum += sacc;
            pw0 = (u32x4){ATT_PK(pA0, 0), ATT_PK(pA0, 2), ATT_PK(pA0, 4), ATT_PK(pA0, 6)}; pw1 = (u32x4){ATT_PK(pA0, 8), ATT_PK(pA0, 10), ATT_PK(pA0, 12), ATT_PK(pA0, 14)};
            pw2 = (u32x4){ATT_PK(pA1, 0), ATT_PK(pA1, 2), ATT_PK(pA1, 4), ATT_PK(pA1, 6)}; pw3 = (u32x4){ATT_PK(pA1, 8), ATT_PK(pA1, 10), ATT_PK(pA1, 12), ATT_PK(pA1, 14)};
            s16x4 vl_[16], vh_[16];
#pragma unroll
            for (int j = 0; j < 16; ++j) { if (j == 0) { VFR_ISSUE(0, vp_); VFR_ISSUE(1, vp_); VFR_ISSUE(2, vp_); VFR_ISSUE(3, vp_); }
                if (j + 4 < 16) VFR_ISSUE(j + 4, vp_);
                VFR_WAIT(j);
                const u32x4 pwj_ = (j >> 2) == 0 ? pw0 : (j >> 2) == 1 ? pw1 : (j >> 2) == 2 ? pw2 : pw3;
                o[j & 3] = __builtin_amdgcn_mfma_f32_32x32x16_bf16(__builtin_bit_cast(bf16x8, pwj_), VFR_GET(j), o[j & 3], 0, 0, 0); }
        }
    }
#undef ATT_WALK
#undef ATT_TOP
#undef ATT_DMA
#undef ATT_DRAIN
#undef ATT_STEP
#undef ATT_GA
#undef ATT_DECIDE
#undef ATT_RESC
#undef KFR
#undef VFR_ISSUE
#undef VFR_WAIT
#undef VFR_WAITN
#undef VFR_GET
#undef VTR_ISSUE
    int lane_e = lane; asm volatile("" : "+v"(lane_e));
    const int r32e = lane_e & 31, hie = lane_e >> 5;
    LAS float* wsfe = (LAS float*)(lds + L_WS) + wid * 64;
    lsum = swapsum(lsum);
    if (hie == 0) wsfe[32 + r32e] = lsum;
    LDS_WAIT();
#pragma unroll
    for (int r = 0; r < 16; ++r) { const float rl = fast_rcp(wsfe[32 + crow(r, hie)]);
#pragma unroll
        for (int db = 0; db < 4; ++db) o[db][r] *= rl; }
    WG_BAR();
    const int nxt = __builtin_amdgcn_readfirstlane((int)lwq[0]) + qlo, rotn = (NTL + rot) & 3;
    if (nxt < qhi) {
        const int jn = nxt - 128, qbn = 31 - (jn >> 6), bn = (jn & 63) >> 3, hn = jn & 7, widn = lane_e >> 6 ? 0 : wid;
        const bf16_t* k1n = P.K + ((size_t)((bn * 8 + hn) * 2) * 64) * 4096 + widn * 512 + lane_e * 8; const bf16_t* k2n = k1n + (size_t)64 * 4096;
        const bf16_t* van = P.V + ((size_t)(bn * 8 + hn) * 64) * 8192 + widn * 512 + lane_e * 8; const bf16_t* vbn = van + 8 * 512;
#pragma unroll
        for (int tn = 0; tn < 2; ++tn) { const int stn = ((tn + rotn) & 3) * STG;
            __builtin_amdgcn_global_load_lds((const GAS unsigned*)(k1n + (size_t)tn * 4096), (LAS unsigned*)(lds + stn + dk1), 16, 0, 0);
            __builtin_amdgcn_global_load_lds((const GAS unsigned*)(k2n + (size_t)tn * 4096), (LAS unsigned*)(lds + stn + dk2), 16, 0, 0);
            __builtin_amdgcn_global_load_lds((const GAS unsigned*)(van + (size_t)tn * 8192), (LAS unsigned*)(lds + stn + dva), 16, 0, 0);
            __builtin_amdgcn_global_load_lds((const GAS unsigned*)(vbn + (size_t)tn * 8192), (LAS unsigned*)(lds + stn + dvb), 16, 0, 0); }
#pragma unroll
        for (int d0 = 0; d0 < 4; ++d0) qr[d0] = *(const bf16x8*)(P.Q + ((size_t)bn * SEQ + qbn * 128 + 32 * qs + r32e) * D + hn * 128 + map * 64 + d0 * 16 + hie * 8);
        if (tid < 128) btp = P.bt[hn * 128 + tid] - P.bt[hn * 128 + 127];
        kmp = P.km2[((bn * 8 + hn) * 2 + map) * 2] + P.km2[((bn * 8 + hn) * 2 + map) * 2 + 1]; bmp = P.bmax[hn];
        if (tid == 0) popv = __hip_atomic_fetch_add(qctr, 1u, __ATOMIC_RELAXED, __HIP_MEMORY_SCOPE_AGENT);
    }
    float sg_[4] = {0.f, 0.f, 0.f, 0.f}, lam = 0.f;
    if (map == 0) { lam = P.lam[0];
#pragma unroll
        for (int db = 0; db < 4; ++db) sg_[db] = P.subg[db * 32 + r32e]; }
    const int xb = STGOF(NTL - 2);
    LAS float* xq = (LAS float*)(lds + xb) + qs * 4096;
    if (map == 1) {
#pragma unroll
        for (int db = 0; db < 4; ++db)
#pragma unroll
            for (int r = 0; r < 16; ++r) xq[crow(r, hie) * 128 + db * 32 + r32e] = o[db][r];
    }
    WG_BAR();
    if (map == 0) {
        float ss[16];
#pragma unroll
        for (int r = 0; r < 16; ++r) { float s = 0.f;
#pragma unroll
            for (int db = 0; db < 4; ++db) { const float v = o[db][r] - lam * xq[crow(r, hie) * 128 + db * 32 + r32e]; o[db][r] = v; s += v * v; }
            ss[r] = s; }
#pragma unroll
        for (int r = 0; r < 16; ++r) { float s = ss[r];
#pragma unroll
            for (int of = 1; of < 32; of <<= 1) s += __shfl_xor(s, of);
            ss[r] = (1.0f - LAM_INIT) / sqrtf(s * (1.0f / 128.0f) + EPS); }
        LAS unsigned char* os = lds + xb + qs * 16384;
#pragma unroll
        for (int db = 0; db < 4; ++db) { const float g = sg_[db];
#pragma unroll
            for (int r = 0; r < 16; ++r) { const unsigned yb = cvtpk(o[db][r] * ss[r] * g, 0.f); *(LAS unsigned short*)(os + crow(r, hie) * OSP + (db * 32 + r32e) * 2) = (unsigned short)(yb & 0xffffu); } }
        LDS_WAIT();
        bf16_t* yg = P.Y + (rowb + qw0) * D + h * 128;
#pragma unroll
        for (int i = 0; i < 8; ++i) { const int cid = i * 64 + lane_e, row = cid >> 4, ch = cid & 15; *(u32x4*)(yg + (size_t)row * D + ch * 8) = *(const LAS u32x4*)(os + row * OSP + ch * 16); }
    }
    WG_BAR();
    item = nxt; rot = rotn; pre = true;
#undef STGOF
}
#undef ATT_PK
}

namespace router {
constexpr int L_LG = 0  , L_HIST = 32768  , L_BASE = 32768 + 128  ;
struct Tensors { const float* x; const bf16_t* delta; const float* g; const bf16_t* rfrag; const float* brouter; bf16_t* hf; unsigned* list; float* rs; float* wt; unsigned* cnt; };
__device__ __forceinline__ void block(LAS unsigned char* lds, const Tensors& P, int tb) {
    const int tid = threadIdx.x, lane = tid & 63, wid = __builtin_amdgcn_readfirstlane(tid >> 6), l16 = lane & 15, q4 = lane >> 4;
    LAS unsigned* hist = (LAS unsigned*)(lds + L_HIST); LAS unsigned* basew = (LAS unsigned*)(lds + L_BASE);
    if (tid < 32) hist[tid] = 0u;
    const int tok = tb * 128 + wid * 16 + l16;
    const float* xrow = P.x + (size_t)tok * D + 8 * q4; const bf16_t* drow = P.delta + (size_t)tok * D + 8 * q4; unsigned char* hrow = (unsigned char*)P.hf + (size_t)tok * D + 8 * q4;
    f32x4 acc0 = {0.f, 0.f, 0.f, 0.f}, acc1 = acc0; float ss = 0.f;
#pragma unroll 4
    for (int ks = 0; ks < 32; ++ks) {
        const f32x4 xa = *(const f32x4*)(xrow + ks * 32), xb = *(const f32x4*)(xrow + ks * 32 + 4);
        const u32x4 dv = *(const u32x4*)(drow + ks * 32);
        const f32x4 ga = *(const f32x4*)(P.g + ks * 32 + 8 * q4), gb = *(const f32x4*)(P.g + ks * 32 + 8 * q4 + 4);
        f32x4 da, db; epi::unpack8(dv, da, db);
        const f32x4 ya = xa + da, yb = xb + db;
        ss += (ya[0] * ya[0] + ya[1] * ya[1]) + (ya[2] * ya[2] + ya[3] * ya[3]) + (yb[0] * yb[0] + yb[1] * yb[1]) + (yb[2] * yb[2] + yb[3] * yb[3]);
        const f32x4 va = ya * ga, vb = yb * gb;
        const u32x4 hw = epi::pack8(va, vb);
        { u32x2 h8; h8.x = cvt4_fp8(va[0], va[1], va[2], va[3]); h8.y = cvt4_fp8(vb[0], vb[1], vb[2], vb[3]); *(u32x2*)(hrow + ks * 32) = h8; }
        f32x4 ha, hb; epi::unpack8(hw, ha, hb);
        const u32x4 lw = epi::pack8(va - ha, vb - hb);
        const bf16x8 bh = __builtin_bit_cast(bf16x8, hw), bl = __builtin_bit_cast(bf16x8, lw);
        const bf16x8* fr = (const bf16x8*)P.rfrag + (size_t)ks * 256 + lane;
        const bf16x8 ah0 = fr[0], al0 = fr[64], ah1 = fr[128], al1 = fr[192];
        acc0 = __builtin_amdgcn_mfma_f32_16x16x32_bf16(ah0, bh, acc0, 0, 0, 0); acc0 = __builtin_amdgcn_mfma_f32_16x16x32_bf16(al0, bh, acc0, 0, 0, 0); acc0 = __builtin_amdgcn_mfma_f32_16x16x32_bf16(ah0, bl, acc0, 0, 0, 0);
        acc1 = __builtin_amdgcn_mfma_f32_16x16x32_bf16(ah1, bh, acc1, 0, 0, 0); acc1 = __builtin_amdgcn_mfma_f32_16x16x32_bf16(al1, bh, acc1, 0, 0, 0); acc1 = __builtin_amdgcn_mfma_f32_16x16x32_bf16(ah1, bl, acc1, 0, 0, 0);
    }
    ss += __shfl_xor(ss, 16); ss += __shfl_xor(ss, 32);
    const float rstd = 1.0f / sqrtf(ss * (1.0f / D) + EPS);
    LAS float* lg = (LAS float*)(lds + L_LG) + (wid * 16 + l16) * 33;
#pragma unroll
    for (int j = 0; j < 4; ++j) { lg[4 * q4 + j] = acc0[j] * rstd + P.brouter[4 * q4 + j]; lg[16 + 4 * q4 + j] = acc1[j] * rstd + P.brouter[16 + 4 * q4 + j]; }
    LB();
    int se[4] = {0, 0, 0, 0}; float sw[4] = {0.f, 0.f, 0.f, 0.f}; unsigned rk[4] = {0u, 0u, 0u, 0u};
    if (q4 == 0) {
        float v[32];
#pragma unroll
        for (int e = 0; e < 32; ++e) v[e] = lg[e];
        float tv[4];
#pragma unroll
        for (int k = 0; k < 4; ++k) { float best = -INFINITY; int bi = 0;
#pragma unroll
            for (int e = 0; e < 32; ++e) { const bool tk = v[e] > best; best = tk ? v[e] : best; bi = tk ? e : bi; }
            tv[k] = best; se[k] = bi;
#pragma unroll
            for (int e = 0; e < 32; ++e) v[e] = (e == bi) ? -INFINITY : v[e]; }
        float den = 0.f;
#pragma unroll
        for (int k = 0; k < 4; ++k) { sw[k] = fast_exp2((tv[k] - tv[0]) * LOG2E); den += sw[k]; }
        const float rd = 1.0f / den;
#pragma unroll
        for (int k = 0; k < 4; ++k) { sw[k] *= rd; rk[k] = __hip_atomic_fetch_add(hist + se[k], 1u, __ATOMIC_RELAXED, __HIP_MEMORY_SCOPE_WORKGROUP); }
    }
    LB();
    if (tid < 32) basew[tid] = __hip_atomic_fetch_add(P.cnt + tid, hist[tid], RLX_AGENT);
    LB();
    if (q4 == 0) {
#pragma unroll
        for (int k = 0; k < 4; ++k) { const size_t pos = (size_t)se[k] * T + basew[se[k]] + rk[k];
            P.list[pos] = (unsigned)tok * 4u + (unsigned)k; P.rs[pos] = rstd; P.wt[pos] = sw[k]; }
    }
    LB();
}
}

__device__ __forceinline__ void final_row(const float* xrow, const bf16_t* drow, const bf16_t* yrows, float* orow, const f32x4 (&g)[4], int lane) {
    f32x4 v[4]; float s = 0.f;
#pragma unroll
    for (int j = 0; j < 4; ++j) { v[j] = *((const f32x4*)xrow + lane + 64 * j);
        const u32x2 dw = *((const u32x2*)drow + lane + 64 * j); v[j] += (f32x4){bflo(dw.x), bfhi(dw.x), bflo(dw.y), bfhi(dw.y)};
#pragma unroll
        for (int k = 0; k < 4; ++k) { const u32x2 yw = *((const u32x2*)(yrows + (size_t)k * D) + lane + 64 * j); v[j] += (f32x4){bflo(yw.x), bfhi(yw.x), bflo(yw.y), bfhi(yw.y)}; }
        s += (v[j].x * v[j].x + v[j].y * v[j].y) + (v[j].z * v[j].z + v[j].w * v[j].w); }
    const float rstd = 1.0f / sqrtf(wave_sum(s) * (1.f / D) + EPS);
#pragma unroll
    for (int j = 0; j < 4; ++j) *((f32x4*)orow + lane + 64 * j) = v[j] * rstd * g[j];
}

constexpr int NPH = 10;
constexpr int N_LAUNCHES = MK_N_LAUNCHES;
__global__ void __launch_bounds__(NTHREADS, 2) hybrid_fwd(Args args) {
    extern __shared__ __attribute__((aligned(16))) unsigned char lds_raw[];
    LAS unsigned char* lds = (LAS unsigned char*)lds_raw;
    LAS unsigned* LW = (LAS unsigned*)(lds + LDSCTL_OFF);
    const int tid = threadIdx.x, lane = tid & 63, wave = __builtin_amdgcn_readfirstlane(tid >> 6);
    const int G = gridDim.x, bx = blockIdx.x;
    unsigned char* ws = args.ws;
    gu32* ctl = (gu32*)(ws + WS_CTL);
    for (int u = tid; u < (LDS_BYTES - LDSCTL_OFF) / 4; u += NTHREADS) LW[u] = 0u;
    __syncthreads();
    XcdBarrier bar; bar.bar = (unsigned*)ctl + CW_BAR; bar.x = 0; bar.st = nullptr;
    if (N_LAUNCHES != NPH) bar = xcd_barrier_post((unsigned*)ctl + CW_BAR + args.li * XCD_BAR_WORDS, (volatile LAS unsigned*)(LW + LW_BAR));
    const int lo = args.ph_lo, hi = args.ph_hi;
#ifndef PH_MASK
#define PH_MASK 0x3ff
#endif
#define IN(k) ((((PH_MASK) >> (k)) & 1) && lo <= (k) && (k) < hi)
#define SEAM(k) do { if (IN(k) && IN((k) + 1)) xcd_barrier(bar); } while (0)
    bf16_t* WinT = (bf16_t*)(ws + WS_WIN_T); bf16_t* WrnnT = (bf16_t*)(ws + WS_WRNN_T); bf16_t* WattT = (bf16_t*)(ws + WS_WATT_T); bf16_t* WoutT = (bf16_t*)(ws + WS_WOUT_T);
    unsigned* LIST = (unsigned*)(ws + WS_LIST); float* RS = (float*)(ws + WS_RS); float* WT = (float*)(ws + WS_WT);
    bf16_t* U1 = (bf16_t*)(ws + WS_U(1)); bf16_t* U2 = (bf16_t*)(ws + WS_U(2)); bf16_t* U3 = (bf16_t*)(ws + WS_U(3)); bf16_t* U4 = (bf16_t*)(ws + WS_U(4));
    bf16_t* U5 = (bf16_t*)(ws + WS_U(5)); bf16_t* U6 = (bf16_t*)(ws + WS_U(6)); bf16_t* U7 = (bf16_t*)(ws + WS_U(7)); bf16_t* U8 = (bf16_t*)(ws + WS_U(8));
    bf16_t* D0 = (bf16_t*)args.out; bf16_t* D1 = D0 + (size_t)T * D;
    unsigned char* misc = ws + WS_MISC;
    bf16_t* RFRAG = (bf16_t*)(misc + MS_RFRAG); float* BT = (float*)(misc + MS_BT); float* SP = (float*)(misc + MS_SP); float* LAM = (float*)(misc + MS_LAM);
    const int gw = bx * NWAVES + wave, NGW = G * NWAVES;

    if (IN(0)) {
        LAS float* scr = (LAS float*)(lds + wave * 16384);
        constexpr int I_IN = (D / 64) * (DIN / 32), I_SQ = (D / 64) * (D / 32);
        for (int it = gw; it < I_IN + 3 * I_SQ; it += NGW) {
            int r = it;
            if (r < I_IN) { p0_transpose_item(args.in[I_WIN], D, DIN, WinT, 0, scr, r, lane); continue; } r -= I_IN;
            if (r < I_SQ) { p0_transpose_item(args.in[I_WPRNN], D, D, WrnnT, 0, scr, r, lane); continue; } r -= I_SQ;
            if (r < I_SQ) { p0_transpose_item(args.in[I_WPATT], D, D, WattT, 0, scr, r, lane); continue; } r -= I_SQ;
            p0_transpose_item(args.in[I_WOUT], D, D, WoutT, 0, scr, r, lane);
        }
        { f32x4 g[4];
#pragma unroll
          for (int j = 0; j < 4; ++j) g[j] = *((const f32x4*)args.in[I_NMG] + lane + 64 * j);
          for (int m = gw; m < T; m += NGW) rms_row_to_bf16(args.in[I_X] + (size_t)m * D, U1 + (size_t)m * D, g, lane); }
        const int gt = bx * NTHREADS + tid, NGT = G * NTHREADS;
        for (int i = gt; i < 32 * 2 * 64; i += NGT) {
            const int ln = i & 63, half = (i >> 6) & 1, ks = i >> 7; float v[8], l[8]; u32x4 wh, wl;
#pragma unroll
            for (int j = 0; j < 8; ++j) v[j] = args.in[I_WROUTER][(size_t)(ks * 32 + 8 * (ln >> 4) + j) * NEXP + half * 16 + (ln & 15)];
            wh = (u32x4){cvtpk(v[0], v[1]), cvtpk(v[2], v[3]), cvtpk(v[4], v[5]), cvtpk(v[6], v[7])};
            l[0] = v[0] - bflo(wh.x); l[1] = v[1] - bfhi(wh.x); l[2] = v[2] - bflo(wh.y); l[3] = v[3] - bfhi(wh.y); l[4] = v[4] - bflo(wh.z); l[5] = v[5] - bfhi(wh.z); l[6] = v[6] - bflo(wh.w); l[7] = v[7] - bfhi(wh.w);
            wl = (u32x4){cvtpk(l[0], l[1]), cvtpk(l[2], l[3]), cvtpk(l[4], l[5]), cvtpk(l[6], l[7])};
            u32x4* dst = (u32x4*)RFRAG + (size_t)ks * 256 + half * 128 + ln; dst[0] = wh; dst[64] = wl;
        }
        for (int i = gt; i < NH * 128; i += NGT) { const int h = i >> 7, n = i & 127; BT[i] = args.in[I_REL][rel_bucket_dev(n) * NH + h] * LOG2E; }
        for (int i = gt; i < D; i += NGT) SP[i] = log1pf(expf(-args.in[I_LAMBDA][i]));
        if (gt < NH) { float mx = 0.f; for (int bk = 0; bk < 32; ++bk) mx = fmaxf(mx, fabsf(args.in[I_REL][bk * NH + gt] - args.in[I_REL][31 * NH + gt])); ((float*)(misc + MS_BMAX))[gt] = mx * LOG2E; }
        if (gt == 0) { float s1 = 0.f, s2 = 0.f; for (int i = 0; i < 64; ++i) { s1 += args.in[I_DLQ1][i] * args.in[I_DLK1][i]; s2 += args.in[I_DLQ2][i] * args.in[I_DLK2][i]; } LAM[0] = expf(s1) - expf(s2) + LAM_INIT; }
    }
    SEAM(0);
    if (IN(1)) {
        pg8::DenseSched S; S.O.init(T, DIN, G, bx); S.A = (const char*)U1; S.Bt = (const char*)WinT;
        epi::EpiProj E; E.out[0] = U2; E.out[1] = U3; E.out[2] = U4; E.out[3] = U5; E.out[4] = U6; E.out[5] = D0; E.out[6] = D1; E.dbg = args.dbg; E.km2 = (unsigned*)ctl + CW_KM2;
        pg8::gemm_phase(lds, S, E);
    }
    SEAM(1);
    if (IN(2)) {
        rglru::Tensors RT{U2, U3, U1, args.in[I_CONVW], args.in[I_CONVB], args.in[I_WRGA], args.in[I_BRGA], args.in[I_WRGX], args.in[I_BRGX], SP};
        att::Tensors AT{U4, U5, U6, U4, BT, args.in[I_SUBG], LAM, (const float*)((const unsigned*)ctl + CW_KM2), (const float*)(misc + MS_BMAX)};
#define POP_ITEM(dst) do { if (tid == 0) LW[LW_Q] = __hip_atomic_fetch_add(ctl + CW_QUEUE, 1u, RLX_AGENT); WG_BAR(); dst = (int)LW[LW_Q]; WG_BAR(); } while (0)
#ifndef PROBE2_MODE
#define PROBE2_MODE 0
#endif
#ifndef PROBE_DBG
#define PROBE_DBG 0
#endif
        const int qlo = (args.li == 1 && PROBE2_MODE == 2) ? 128 : 0, qhi = (args.li == 1 && PROBE2_MODE == 1) ? 128 : 128 + 2048;
        int item; POP_ITEM(item); item += qlo;
#pragma unroll 1
        while (item < 128) { rglru::unit(lds, RT, item >> 4, item & 15); POP_ITEM(item); item += qlo; }
        if (item < qhi) {
            { int n2; POP_ITEM(n2); (void)n2; }
            int rot = 0; bool pre = false; unsigned popv = 0u; float btp = 0.f, kmp = 0.f, bmp = 0.f; bf16x8 qr[4];
#pragma unroll
            for (int d0 = 0; d0 < 4; ++d0) qr[d0] = (bf16x8){0, 0, 0, 0, 0, 0, 0, 0};
#pragma unroll 1
            while (item < qhi) att::unit(lds, AT, item, rot, pre, popv, btp, kmp, bmp, qr, qlo, qhi, ctl + CW_QUEUE);
        }
#undef POP_ITEM
    }
    SEAM(2);
    if (IN(3)) {
        LAS float* scr = (LAS float*)(lds + wave * 16384);
        constexpr int I_SQ = (D / 64) * (D / 32);
        const bool copy_first = ((bx >> 3) & 1) != 0;
#define WCOPY_ALL() do { _Pragma("unroll 1") for (int it = gw; it < 3 * NEXP * I_SQ; it += NGW) { const int mat = it / (NEXP * I_SQ), r = it % (NEXP * I_SQ), e = r / I_SQ, ii = r % I_SQ; \
            const float* W = args.in[mat == 0 ? I_WGATE : (mat == 1 ? I_WUP : I_WDOWN)] + (size_t)e * D * D; unsigned char* WTp = (unsigned char*)(mat == 0 ? U3 : (mat == 1 ? U5 : U6)); \
            p0_transpose_item_fp8(W, D, D, WTp, e * D, scr, ii, lane, 32.0f); } } while (0)
        if (copy_first) WCOPY_ALL();
        __syncthreads();
        { pg8::DualSched S; S.O.init(T, D, G, bx); S.A0 = (const char*)U1; S.Bt0 = (const char*)WrnnT; S.A1 = (const char*)U4; S.Bt1 = (const char*)WattT;
          epi::EpiMerge E{U8, U2, D0, D1};
          pg8::gemm_phase(lds, S, E); }
        __syncthreads();
        if (!copy_first) WCOPY_ALL();
#undef WCOPY_ALL
    }
    SEAM(3);
    if (IN(4)) { }
    if (IN(5)) {
        pg8::DenseSched S; S.O.init(T, D, G, bx); S.A = (const char*)U2; S.Bt = (const char*)WoutT;
        epi::EpiGate<false, false> E{U7, nullptr, nullptr};
        pg8::gemm_phase(lds, S, E);
    }
    SEAM(5);
    if (IN(6)) {
        router::Tensors RT{args.in[I_X], U7, args.in[I_NFG], RFRAG, args.in[I_BROUTER], U1, LIST, RS, WT, (unsigned*)ctl + CW_CNT};
        for (int tb = bx; tb < T / 128; tb += G) router::block(lds, RT, tb);
    }
    SEAM(6);
    if (IN(7) || IN(8)) {
        { int t2 = tid; asm volatile("" : "+v"(t2));
          if (t2 < 32) LW[LW_CNT + t2] = __hip_atomic_load(ctl + CW_CNT + t2, RLX_AGENT); }
        __syncthreads();
        if (tid == 0) { unsigned acc = 0u; for (int e = 0; e < 32; ++e) { LW[LW_TS + e] = acc; acc += (LW[LW_CNT + e] + 255u) >> 8; } LW[LW_TS + 32] = acc; }
        __syncthreads();
    }
    unsigned char* actb[2] = {(unsigned char*)D0, ws + WS_S};
    if (IN(7)) {
        epi::MoeSched<8, true> S; S.G = G; S.c = bx; S.ntl = __builtin_amdgcn_readfirstlane((int)LW[LW_TS + 32]); S.ts = (const LAS int*)(LW + LW_TS); S.cn = (const LAS int*)(LW + LW_CNT);
        S.A = (const char*)U1; S.list = LIST; S.W0 = (const char*)U3; S.W1 = (const char*)U5;
        S.actbase[0] = actb[0]; S.actbase[1] = actb[1];
        epi::EpiGU E; E.bg = args.in[I_BGATE]; E.bu = args.in[I_BUP]; E.rs = RS; E.actbase[0] = actb[0]; E.actbase[1] = actb[1];
        pg8::gemm_phase<epi::EpiGU, epi::MoeSched<8, true>, true>(lds, S, E);
    }
    SEAM(7);
    if (IN(8)) {
        epi::MoeSched<4, false> S; S.G = G; S.c = bx; S.ntl = __builtin_amdgcn_readfirstlane((int)LW[LW_TS + 32]); S.ts = (const LAS int*)(LW + LW_TS); S.cn = (const LAS int*)(LW + LW_CNT);
        S.A = nullptr; S.list = LIST; S.W0 = (const char*)U6; S.W1 = nullptr;
        S.actbase[0] = actb[0]; S.actbase[1] = actb[1];
        epi::EpiDown E; E.bd = args.in[I_BDOWN]; E.wt = WT; E.list = LIST; E.ybase = (unsigned char*)U1; E.junk = misc + 512 * 1024;
        pg8::gemm_phase<epi::EpiDown, epi::MoeSched<4, false>, true>(lds, S, E);
    }
    SEAM(8);
    if (IN(9)) {
        f32x4 g[4];
#pragma unroll
        for (int j = 0; j < 4; ++j) g[j] = *((const f32x4*)args.in[I_NFINAL] + lane + 64 * j);
        for (int m = gw; m < T; m += NGW) { const bf16_t* yb = U1 + (size_t)m * 4 * D;
            final_row(args.in[I_X] + (size_t)m * D, U7 + (size_t)m * D, yb, args.out + (size_t)m * D, g, lane); }
    }
#undef IN
#undef SEAM
}

extern "C" void kernel_launch(void* const* d_in, const int* in_sizes, int n_in, void* d_out, int out_size, void* d_ws, size_t ws_size, hipStream_t stream) {
    static int grid = 0;
    if (grid == 0) {
        if (n_in != 29 || in_sizes[0] != T * D || out_size != T * D || ws_size < WS_END) { fprintf(stderr, "kernel_launch: unexpected shapes / workspace (n_in %d, ws %zu < %zu)\n", n_in, ws_size, (size_t)WS_END); grid = -1; return; }
        int dev = 0, cus = 0;
        if (hipGetDevice(&dev) != hipSuccess || hipDeviceGetAttribute(&cus, hipDeviceAttributeMultiprocessorCount, dev) != hipSuccess) { grid = -1; return; }
        if (hipFuncSetAttribute((const void*)hybrid_fwd, hipFuncAttributeMaxDynamicSharedMemorySize, LDS_BYTES) != hipSuccess) { fprintf(stderr, "kernel_launch: hipFuncSetAttribute failed\n"); grid = -1; return; }
        int per_cu = 0;
        if (hipOccupancyMaxActiveBlocksPerMultiprocessor(&per_cu, (const void*)hybrid_fwd, NTHREADS, LDS_BYTES) != hipSuccess || per_cu < 1) fprintf(stderr, "kernel_launch: occupancy query reports %d\n", per_cu);
        (void)hipGetLastError();
        grid = cus;
    }
    if (grid < 0) return;
    (void)hipMemsetAsync((char*)d_ws + WS_CTL, 0, CTL_ZERO_BYTES, stream);
    Args a{};
    for (int i = 0; i < 29; ++i) a.in[i] = (const float*)d_in[i];
    a.out = (float*)d_out; a.ws = (unsigned char*)d_ws;
#if defined(PROBE_PHASE)
    { const int k = PROBE_PHASE;
      if (k == 2) {
        a.ph_lo = 0; a.ph_hi = NPH; a.li = 0; hipLaunchKernelGGL(hybrid_fwd, dim3(grid), dim3(NTHREADS), LDS_BYTES, stream, a);
        (void)hipMemsetAsync((char*)d_ws + WS_CTL + CW_QUEUE * 4, 0, 4, stream);
        a.ph_lo = 2; a.ph_hi = 3; a.li = 1; hipLaunchKernelGGL(hybrid_fwd, dim3(grid), dim3(NTHREADS), LDS_BYTES, stream, a);
      } else {
        a.ph_lo = 0; a.ph_hi = k + 1; a.li = 0; hipLaunchKernelGGL(hybrid_fwd, dim3(grid), dim3(NTHREADS), LDS_BYTES, stream, a);
        if (k == 6) (void)hipMemsetAsync((char*)d_ws + WS_CTL + CW_CNT * 4, 0, 32 * 4, stream);
        a.ph_lo = k; a.ph_hi = k + 1; a.li = 1; a.dbg = PROBE_DBG; hipLaunchKernelGGL(hybrid_fwd, dim3(grid), dim3(NTHREADS), LDS_BYTES, stream, a);
        a.dbg = 0;
        if (k + 1 < NPH) { a.ph_lo = k + 1; a.ph_hi = NPH; a.li = 2; hipLaunchKernelGGL(hybrid_fwd, dim3(grid), dim3(NTHREADS), LDS_BYTES, stream, a); }
      } }
#else
    if (N_LAUNCHES == 1) { a.ph_lo = 0; a.ph_hi = NPH; a.li = 0; hipLaunchKernelGGL(hybrid_fwd, dim3(grid), dim3(NTHREADS), LDS_BYTES, stream, a); }
    else for (int p = 0; p < NPH; ++p) { a.ph_lo = p; a.ph_hi = p + 1; a.li = 0; hipLaunchKernelGGL(hybrid_fwd, dim3(grid), dim3(NTHREADS), LDS_BYTES, stream, a); }
#endif
}
```

```cpp
#include <hip/hip_runtime.h>
#include <cstdio>
#include <cstdint>
#include <cmath>

#ifndef MK_N_LAUNCHES
#define MK_N_LAUNCHES 1
#endif

#define GAS __attribute__((address_space(1)))
#define LAS __attribute__((address_space(3)))
typedef unsigned short bf16_t;
typedef short bf16x8 __attribute__((ext_vector_type(8)));
typedef short s16x4 __attribute__((ext_vector_type(4)));
typedef float f32x2 __attribute__((ext_vector_type(2)));
typedef float f32x4 __attribute__((ext_vector_type(4)));
typedef float f32x16 __attribute__((ext_vector_type(16)));
typedef unsigned u32x2 __attribute__((ext_vector_type(2)));
typedef unsigned u32x4 __attribute__((ext_vector_type(4)));
typedef __bf16 bf16x2_t __attribute__((ext_vector_type(2)));
typedef GAS unsigned gu32;

constexpr int BATCH = 8, SEQ = 4096, D = 1024, T = BATCH * SEQ;
constexpr int DIN = 7168, NH = 8, NEXP = 32, TOPK = 4, NPAIR = T * TOPK;
constexpr float EPS = 1e-6f, LOG2E = 1.4426950408889634f;
constexpr float QSCALE = 0.125f * LOG2E;
constexpr float LAM_INIT = 0.2f;

constexpr size_t MiB = 1u << 20;
constexpr size_t WS_CTL = 0, CTL_ZERO_BYTES = 64 * 1024;
constexpr size_t WS_MISC = 1 * MiB;
constexpr size_t WS_WIN_T = 2 * MiB;
constexpr size_t WS_LIST = 2 * MiB, WS_RS = 6 * MiB, WS_WT = 10 * MiB;
constexpr size_t WS_WRNN_T = 16 * MiB, WS_WATT_T = 18 * MiB, WS_WOUT_T = 20 * MiB;
constexpr size_t UNIT = 64 * MiB;
constexpr size_t WS_U(int i) { return 24 * MiB + (size_t)(i - 1) * UNIT; }
constexpr size_t WS_S = 536 * MiB;
constexpr size_t WS_END = 552 * MiB;
constexpr size_t MS_RFRAG = 0;
constexpr size_t MS_BT = 128 * 1024;
constexpr size_t MS_SP = 132 * 1024;
constexpr size_t MS_LAM = 136 * 1024;
constexpr size_t MS_BMAX = 140 * 1024;
constexpr int NBF = 5120;
constexpr int CW_TMO = 0, CW_CODE = 1, CW_QUEUE = 64, CW_CNT = 128  , CW_KM2 = 256  , CW_BAR = 4096;

constexpr int RING_BYTES = 131072, LDSCTL_OFF = RING_BYTES, LDS_BYTES = 147456;
constexpr int LW_BAR = 0  , LW_Q = 8  , LW_TS = 16  , LW_CNT = 64  , LW_MISC = 128;

#define RLX_AGENT __ATOMIC_RELAXED, __HIP_MEMORY_SCOPE_AGENT
#define LDS_WAIT() asm volatile("s_waitcnt lgkmcnt(0)" ::: "memory")
#define VM_WAIT() asm volatile("s_waitcnt vmcnt(0)" ::: "memory")
#define WG_BAR() asm volatile("s_waitcnt vmcnt(0) lgkmcnt(0)\n\ts_barrier" ::: "memory")
#define SBAR() __builtin_amdgcn_sched_barrier(0)
__device__ __forceinline__ unsigned cvtpk(float lo, float hi) { f32x2 v = {lo, hi}; bf16x2_t b = __builtin_convertvector(v, bf16x2_t); return __builtin_bit_cast(unsigned, b); }
__device__ __forceinline__ unsigned cvt4_fp8(float a, float b, float c, float d) { unsigned w = 0u; w = __builtin_amdgcn_cvt_pk_fp8_f32(a, b, w, false); w = __builtin_amdgcn_cvt_pk_fp8_f32(c, d, w, true); return w; }
__device__ __forceinline__ float bf2f(unsigned short h) { return __uint_as_float((unsigned)h << 16); }
__device__ __forceinline__ float bflo(unsigned w) { return __uint_as_float(w << 16); }
__device__ __forceinline__ float bfhi(unsigned w) { return __uint_as_float(w & 0xffff0000u); }
__device__ __forceinline__ float fast_exp2(float x) { return __builtin_amdgcn_exp2f(x); }
__device__ __forceinline__ float fast_rcp(float x) { return __builtin_amdgcn_rcpf(x); }
__device__ __forceinline__ float sigmoidf_(float x) { return fast_rcp(1.0f + fast_exp2(-x * LOG2E)); }
__device__ __forceinline__ float wave_sum(float v) {
#pragma unroll
    for (int o = 1; o < 64; o <<= 1) v += __shfl_xor(v, o);
    return v;
}

namespace pg8 {
constexpr int BM = 256, BK = 64, HALF = 128, HTB = HALF * BK * 2, STAGE_BYTES = 8 * HTB, KD = 1024;
__host__ __device__ __forceinline__ int lds_byte(int r, int c) { const int st = (r >> 4) * 2 + (c >> 5), rr = r & 15, cc = c & 31, ob = rr * 64 + cc * 2; return st * 1024 + (ob ^ (((ob >> 9) & 1) << 5)); }
__host__ __device__ __forceinline__ void stage_rc(int b, int& R, int& C) { const int st = b / 1024, sb = b % 1024, swz = sb ^ (((sb >> 9) & 1) << 5); R = (st >> 1) * 16 + swz / 64; C = (st & 1) * 32 + (swz % 64) / 2; }
__host__ __device__ __forceinline__ int perm32(int rho) { const int n = rho >> 4, i = rho & 15; return 8 * (i >> 2) + 4 * n + (i & 3); }

__host__ __device__ __forceinline__ size_t btile_off(int n, int kb, int ntb) {
    const int x = n & 31, rho = 16 * ((x >> 2) & 1) + 4 * (x >> 3) + (x & 3), slot = (n & 96) + rho;
    return ((size_t)(n >> 7) * ntb + (kb >> 7)) * 16384 + lds_byte(slot, (kb & 127) >> 1) + (kb & 1);
}
struct UnitG { const char* A; const char* B0; const char* B1; unsigned tk0, tk1; int x0, x1, x2, x3, x4; };

struct TileOrder {
    int nM, nN, nwg, G, c;
    __device__ void init(int M, int N, int G_, int c_) { nM = M / BM; nN = N / BM; nwg = nM * nN; G = G_; c = c_; }
    __device__ bool tile(int i, int& pm, int& pn) const {
        const long L = (long)i * G + c; if (L >= nwg) return false;
        int wgid = (int)L; { const int q = nwg / 8, r = nwg % 8, xcd = wgid % 8, off = wgid / 8; wgid = (xcd < r ? xcd * (q + 1) : r * (q + 1) + (xcd - r) * q) + off; }
        const int nig = 8 * nN, gid = wgid / nig, fm = gid * 8, gsz = (nM - fm) < 8 ? (nM - fm) : 8;
        pm = fm + ((wgid % nig) % gsz); pn = (wgid % nig) / gsz; return true;
    }
};
struct DenseSched {
    TileOrder O; const char* A; const char* Bt;
    __device__ bool next(int i, UnitG& u) const {
        int pm, pn; if (!O.tile(i, pm, pn)) return false;
        u.A = A + (size_t)pm * (BM * KD * 2); u.B0 = Bt + (size_t)pn * (BM * KD * 2); u.B1 = u.B0 + (size_t)HALF * KD * 2;
        u.tk0 = 0u; u.tk1 = 0u; u.x0 = pm; u.x1 = pn; u.x2 = 0; u.x3 = 0; u.x4 = 0; return true;
    }
    __device__ __forceinline__ void expand(const UnitG&, unsigned& o0, unsigned& o1, unsigned& o2, unsigned& o3) const {
        int R, C; stage_rc((int)threadIdx.x * 16, R, C); o0 = (unsigned)(R * KD + C) * 2u; stage_rc((int)threadIdx.x * 16 + 8192, R, C); o1 = (unsigned)(R * KD + C) * 2u;
        o2 = o0 + (unsigned)(HALF * KD * 2); o3 = o1 + (unsigned)(HALF * KD * 2);
    }
};

struct DenseSched8 {
    TileOrder O; const char* A; const char* Bt; int pn_off;
    __device__ bool next(int i, UnitG& u) const {
        int pm, pn; if (!O.tile(i, pm, pn)) return false;
        u.A = A + (size_t)pm * (BM * 1024); u.B0 = Bt + (size_t)pn * (BM * 1024); u.B1 = u.B0 + (size_t)HALF * 1024;
        u.tk0 = 0u; u.tk1 = 0u; u.x0 = pm; u.x1 = pn + pn_off; u.x2 = 0; u.x3 = 0; u.x4 = 0; return true;
    }
    __device__ __forceinline__ void expand(const UnitG&, unsigned& o0, unsigned& o1, unsigned& o2, unsigned& o3) const {
        int R, C; stage_rc((int)threadIdx.x * 16, R, C); o0 = (unsigned)(R * 1024 + C * 2); stage_rc((int)threadIdx.x * 16 + 8192, R, C); o1 = (unsigned)(R * 1024 + C * 2);
        o2 = o0 + 128u * 1024u; o3 = o1 + 128u * 1024u;
        asm volatile("" : "+v"(o0), "+v"(o1), "+v"(o2), "+v"(o3));
    }
};

typedef int i32x4 __attribute__((ext_vector_type(4)));
typedef int i32x8 __attribute__((ext_vector_type(8)));
__device__ __forceinline__ i32x8 cat8(const bf16x8 a, const bf16x8 b) { return __builtin_shufflevector(__builtin_bit_cast(i32x4, a), __builtin_bit_cast(i32x4, b), 0, 1, 2, 3, 4, 5, 6, 7); }
struct DualSched {
    TileOrder O; const char* A0; const char* Bt0; const char* A1; const char* Bt1;
    __device__ bool next(int i, UnitG& u) const {
        int pm, pn; if (!O.tile(i >> 1, pm, pn)) return false;
        const int g = i & 1;
        u.A = (g ? A1 : A0) + (size_t)pm * (BM * KD * 2); u.B0 = (g ? Bt1 : Bt0) + (size_t)pn * (BM * KD * 2); u.B1 = u.B0 + (size_t)HALF * KD * 2;
        u.tk0 = 0u; u.tk1 = 0u; u.x0 = pm; u.x1 = pn; u.x2 = g; u.x3 = 0; u.x4 = 0; return true;
    }
    __device__ __forceinline__ void expand(const UnitG&, unsigned& o0, unsigned& o1, unsigned& o2, unsigned& o3) const {
        int R, C; stage_rc((int)threadIdx.x * 16, R, C); o0 = (unsigned)(R * KD + C) * 2u; stage_rc((int)threadIdx.x * 16 + 8192, R, C); o1 = (unsigned)(R * KD + C) * 2u;
        o2 = o0 + (unsigned)(HALF * KD * 2); o3 = o1 + (unsigned)(HALF * KD * 2);
    }
};
template <class Epi, class Sched, bool FP8 = false>
__device__ __forceinline__ void gemm_phase(LAS unsigned char* lds, const Sched& S, const Epi& E) {
    constexpr int PB = FP8 ? 1024 : 2048, NT = FP8 ? 8 : 16;
    const int tid = threadIdx.x, wid = __builtin_amdgcn_readfirstlane(tid >> 6), lane = tid & 63, wr = wid >> 2, wc = wid & 3, fr = lane & 15, fq = lane >> 4;
    static_assert(Epi::PERM, "weights are stored in the PERM tiled layout");
    const unsigned voffB0 = (unsigned)tid * 16u;
    constexpr size_t kstep = (size_t)(BK * 2), kstepB = 16384;
    const unsigned ldsw = (unsigned)wid * 1024u;
    const int aoff = lds_byte(wr * 64 + fr, fq * 8), boff = lds_byte(wc * 32 + fr, fq * 8);
#define PG8_SA(b, h) (((b) * 2 + (h)) * HTB)
#define PG8_SB(b, h) ((4 + (b) * 2 + (h)) * HTB)
#define PG8_STAGEB(bufoff, gbase) do { _Pragma("unroll") for (int _i = 0; _i < 2; ++_i) \
        __builtin_amdgcn_global_load_lds((const GAS unsigned*)((const char*)(gbase) + voffB0 + _i * 8192), (LAS unsigned*)(lds + (bufoff) + ldsw + _i * 8192), 16, 0, 0); } while (0)
#define PG8_STAGEA(bufoff, gbase, oa, ob) do { \
        __builtin_amdgcn_global_load_lds((const GAS unsigned*)((const char*)(gbase) + (oa)), (LAS unsigned*)(lds + (bufoff) + ldsw), 16, 0, 0); \
        __builtin_amdgcn_global_load_lds((const GAS unsigned*)((const char*)(gbase) + (ob)), (LAS unsigned*)(lds + (bufoff) + ldsw + 8192), 16, 0, 0); } while (0)
#define PG8_LDA(dst, b, h) do { _Pragma("unroll") for (int m = 0; m < 4; ++m) { const i32x4 l0_ = *(const LAS i32x4*)(lds + PG8_SA(b, h) + aoff + m * 2048), l1_ = *(const LAS i32x4*)(lds + PG8_SA(b, h) + aoff + m * 2048 + 1024); dst[m] = __builtin_shufflevector(l0_, l1_, 0, 1, 2, 3, 4, 5, 6, 7); } } while (0)
#define PG8_LDB(dst, b, h) do { _Pragma("unroll") for (int n = 0; n < 2; ++n) { const i32x4 l0_ = *(const LAS i32x4*)(lds + PG8_SB(b, h) + boff + n * 2048), l1_ = *(const LAS i32x4*)(lds + PG8_SB(b, h) + boff + n * 2048 + 1024); dst[n] = __builtin_shufflevector(l0_, l1_, 0, 1, 2, 3, 4, 5, 6, 7); } } while (0)
#define PG8_HALF(v, k) __builtin_bit_cast(bf16x8, __builtin_shufflevector(v, v, 4 * (k), 4 * (k) + 1, 4 * (k) + 2, 4 * (k) + 3))
#define PG8_MMA(ai, bj, At, Bt) do { __builtin_amdgcn_s_setprio(1); _Pragma("unroll") for (int m = 0; m < 4; ++m) _Pragma("unroll") for (int n = 0; n < 2; ++n) { \
        if constexpr (FP8) acc[ai][bj][m][n] = __builtin_amdgcn_mfma_scale_f32_16x16x128_f8f6f4(Bt[n], At[m], acc[ai][bj][m][n], 0, 0, 0, 0x7f7f7f7f, 0, 0x7f7f7f7f); \
        else { acc[ai][bj][m][n] = __builtin_amdgcn_mfma_f32_16x16x32_bf16(PG8_HALF(Bt[n], 0), PG8_HALF(At[m], 0), acc[ai][bj][m][n], 0, 0, 0); acc[ai][bj][m][n] = __builtin_amdgcn_mfma_f32_16x16x32_bf16(PG8_HALF(Bt[n], 1), PG8_HALF(At[m], 1), acc[ai][bj][m][n], 0, 0, 0); } } __builtin_amdgcn_s_setprio(0); } while (0)
#define PG8_WAIT_V(n) asm volatile("s_waitcnt vmcnt(" #n ")" ::: "memory")
#define PG8_WAIT_L(n) asm volatile("s_waitcnt lgkmcnt(" #n ")" ::: "memory")
#define PG8_BAR __builtin_amdgcn_s_barrier()
#define PG8_SCHED __builtin_amdgcn_sched_barrier(0)
    UnitG cur, nxt; int ui = 0;
    if (!S.next(0, cur)) return;
    f32x4 acc[2][2][4][2];
#pragma unroll
    for (int a = 0; a < 2; ++a)
#pragma unroll
        for (int b = 0; b < 2; ++b)
#pragma unroll
            for (int m = 0; m < 4; ++m)
#pragma unroll
                for (int n = 0; n < 2; ++n) acc[a][b][m][n] = (f32x4){0.f, 0.f, 0.f, 0.f};
    i32x8 At[4], B0[2], B1[2];
    const char* cA = cur.A; const char* cB0 = cur.B0; const char* cB1 = cur.B1;
    unsigned ca0, ca1, ca2, ca3; S.expand(cur, ca0, ca1, ca2, ca3);
    PG8_STAGEB(PG8_SB(0, 0), cB0); PG8_STAGEB(PG8_SB(0, 1), cB1); PG8_STAGEA(PG8_SA(0, 0), cA, ca0, ca1); PG8_STAGEA(PG8_SA(0, 1), cA, ca2, ca3);
    if (wr == 1) PG8_BAR;
    PG8_WAIT_V(2); PG8_BAR;
    PG8_STAGEB(PG8_SB(1, 0), cB0 + kstepB); PG8_STAGEA(PG8_SA(1, 0), cA + kstep, ca0, ca1); PG8_STAGEB(PG8_SB(1, 1), cB1 + kstepB);
    PG8_WAIT_V(6); PG8_BAR;
    for (;;) {
        const bool has_next = S.next(ui + 1, nxt);
        const char* nA = has_next ? nxt.A : cA; const char* nB0 = has_next ? nxt.B0 : cB0; const char* nB1 = has_next ? nxt.B1 : cB1;
#pragma unroll 1
        for (int t = 0; t < NT; t += 2) {
            const bool last = (t == NT - 2);
            const char* a1 = cA + (size_t)(t + 1) * kstep;
            const char* a2 = last ? nA : cA + (size_t)(t + 2) * kstep;
            const char* b02 = last ? nB0 : cB0 + (size_t)(t + 2) * kstepB; const char* b12 = last ? nB1 : cB1 + (size_t)(t + 2) * kstepB;
            const char* a3 = a2 + kstep; const char* b03 = b02 + kstepB; const char* b13 = b12 + kstepB;
            PG8_LDB(B0, 0, 0); PG8_LDB(B1, 0, 1); PG8_SCHED; PG8_LDA(At, 0, 0); PG8_STAGEA(PG8_SA(1, 1), a1, ca2, ca3);
            if (last && has_next) S.expand(nxt, ca0, ca1, ca2, ca3);
            if constexpr (Epi::NSTORES == 16) { if (t == 0 && ui > 0) PG8_WAIT_V(24); else PG8_WAIT_V(8); } else PG8_WAIT_V(8);
            PG8_WAIT_L(0); PG8_BAR; PG8_MMA(0, 0, At, B0); PG8_MMA(0, 1, At, B1); PG8_BAR; PG8_SCHED;
            PG8_LDA(At, 0, 1); PG8_STAGEB(PG8_SB(0, 0), b02); PG8_STAGEB(PG8_SB(0, 1), b12); PG8_STAGEA(PG8_SA(0, 0), a2, ca0, ca1);
            if constexpr (Epi::NSTORES == 16) { if (t == 0 && ui > 0) PG8_WAIT_V(24); else PG8_WAIT_V(8); } else PG8_WAIT_V(8);
            PG8_WAIT_L(0); PG8_BAR; PG8_MMA(1, 0, At, B0); PG8_MMA(1, 1, At, B1); PG8_BAR; PG8_SCHED;
            PG8_LDB(B0, 1, 0); PG8_LDB(B1, 1, 1); PG8_SCHED; PG8_LDA(At, 1, 0); PG8_STAGEA(PG8_SA(0, 1), a2, ca2, ca3);
            PG8_WAIT_V(8); PG8_WAIT_L(0); PG8_BAR; PG8_MMA(0, 0, At, B0); PG8_MMA(0, 1, At, B1); PG8_BAR; PG8_SCHED;
            PG8_LDA(At, 1, 1); PG8_STAGEB(PG8_SB(1, 0), b03); PG8_STAGEB(PG8_SB(1, 1), b13); PG8_STAGEA(PG8_SA(1, 0), a3, ca0, ca1);
            PG8_WAIT_V(8); PG8_WAIT_L(0); PG8_BAR; PG8_MMA(1, 0, At, B0); PG8_MMA(1, 1, At, B1); PG8_BAR; PG8_SCHED;
        }
        if (wr == 0) PG8_BAR;
        E(acc, cur, wr, wc, fr, fq);
        if (!has_next) break;
#pragma unroll
        for (int a = 0; a < 2; ++a)
#pragma unroll
            for (int b = 0; b < 2; ++b)
#pragma unroll
                for (int m = 0; m < 4; ++m)
#pragma unroll
                    for (int n = 0; n < 2; ++n) acc[a][b][m][n] = (f32x4){0.f, 0.f, 0.f, 0.f};
        cur = nxt; cA = nA; cB0 = nB0; cB1 = nB1;
        ++ui;
        if (wr == 1) PG8_BAR;
    }
    PG8_WAIT_V(0);
    PG8_BAR;
#undef PG8_SA
#undef PG8_SB
#undef PG8_STAGEA
#undef PG8_STAGEB
#undef PG8_LDA
#undef PG8_LDB
#undef PG8_MMA
#undef PG8_WAIT_V
#undef PG8_WAIT_L
#undef PG8_BAR
#undef PG8_SCHED
}
}

namespace epi {
using pg8::UnitG;
__device__ __forceinline__ u32x4 pack8(const f32x4 v0, const f32x4 v1) { u32x4 w; w.x = cvtpk(v0[0], v0[1]); w.y = cvtpk(v0[2], v0[3]); w.z = cvtpk(v1[0], v1[1]); w.w = cvtpk(v1[2], v1[3]); return w; }
__device__ __forceinline__ void unpack8(const u32x4 w, f32x4& v0, f32x4& v1) { v0 = (f32x4){bflo(w.x), bfhi(w.x), bflo(w.y), bfhi(w.y)}; v1 = (f32x4){bflo(w.z), bfhi(w.z), bflo(w.w), bfhi(w.w)}; }

template <bool F8> struct EpiProjT {
    static constexpr bool PERM = true; static constexpr int NSTORES = 0;
    bf16_t* out[7]; int dbg; unsigned* km2;
    __device__ __forceinline__ void operator()(const f32x4 (&acc)[2][2][4][2], const UnitG& u, int wr, int wc, int fr, int fq) const {
        asm volatile("" : "+v"(fr), "+v"(fq));
        const int reg = u.x1 >> 2; bf16_t* base = reg == 0 ? out[0] : reg == 1 ? out[1] : reg == 2 ? out[2] : reg == 3 ? out[3] : reg == 4 ? out[4] : reg == 5 ? out[5] : out[6];
        const int row0 = u.x0 * 256 + wr * 64 + fr, col0 = (u.x1 & 3) * 256 + wc * 32 + 8 * fq;
        float kss[2] = {0.f, 0.f};
#pragma unroll
        for (int ai = 0; ai < 2; ++ai)
#pragma unroll
            for (int m = 0; m < 4; ++m) { const int row = row0 + ai * 128 + m * 16; bf16_t* rowp = base + (size_t)row * D + col0;
                const int bq = row >> 12, sq = row & 4095, tile = sq >> 6, key = sq & 63;
#pragma unroll
                for (int bj = 0; bj < 2; ++bj) { f32x4 v0 = acc[ai][bj][m][0], v1 = acc[ai][bj][m][1];
                    if (F8) { v0 = v0 * (1.0f / 32.0f); v1 = v1 * (1.0f / 32.0f); }
                    if (reg >= 5) {
#pragma unroll
                        for (int j = 0; j < 4; ++j) { v0[j] = sigmoidf_(v0[j]); v1[j] = sigmoidf_(v1[j]); } }
                    else if (reg == 2) { v0 = v0 * QSCALE; v1 = v1 * QSCALE; }
                    u32x4* dst = (u32x4*)(rowp + bj * 128);
                    if (reg == 3 || reg == 4) { const int col = col0 + bj * 128, hh = col >> 7;
                        const size_t off16 = (reg == 3) ? ((((size_t)((bq * 8 + hh) * 2 + ((col >> 6) & 1)) * 64 + tile) * 8 + ((col >> 3) & 7)) * 64 + key)
                                                        : ((((size_t)(bq * 8 + hh) * 64 + tile) * 16 + ((col >> 5) & 3) * 4 + (key >> 4)) * 64 + (key & 15) * 4 + ((col >> 3) & 3));
                        dst = (u32x4*)base + off16; }
                    if (!(dbg & 1)) __builtin_nontemporal_store(pack8(v0, v1), dst);
                    if (reg == 3) { kss[bj] = fmaxf(kss[bj], (v0[0] * v0[0] + v0[1] * v0[1]) + (v0[2] * v0[2] + v0[3] * v0[3]) + (v1[0] * v1[0] + v1[1] * v1[1]) + (v1[2] * v1[2] + v1[3] * v1[3])); } } }
        if (reg == 3) {
#pragma unroll
            for (int bj = 0; bj < 2; ++bj) { float s = kss[bj];
                s += __shfl_xor(s, 16); s += __shfl_xor(s, 32);
#pragma unroll
                for (int of = 1; of < 16; of <<= 1) s = fmaxf(s, __shfl_xor(s, of));
                if ((fr | fq) == 0) __hip_atomic_fetch_max(km2 + (((u.x0 >> 4) * 8 + (u.x1 & 3) * 2 + bj) * 2 + (wc >> 1)) * 2 + (wc & 1), __float_as_uint(s), RLX_AGENT); } }
    }
};
using EpiProj = EpiProjT<false>;
template <bool GATE, bool ADD> struct EpiGate {
    static constexpr bool PERM = true; static constexpr int NSTORES = 0;
    bf16_t* out; const bf16_t* gate; const bf16_t* addsrc;
    __device__ __forceinline__ void operator()(const f32x4 (&acc)[2][2][4][2], const UnitG& u, int wr, int wc, int fr, int fq) const {
        asm volatile("" : "+v"(fr), "+v"(fq));
        const int row0 = u.x0 * 256 + wr * 64 + fr, col0 = u.x1 * 256 + wc * 32 + 8 * fq;
#pragma unroll
        for (int ai = 0; ai < 2; ++ai)
#pragma unroll
            for (int m = 0; m < 4; ++m) { const size_t off = (size_t)(row0 + ai * 128 + m * 16) * D + col0;
#pragma unroll
                for (int bj = 0; bj < 2; ++bj) { f32x4 v0 = acc[ai][bj][m][0], v1 = acc[ai][bj][m][1];
                    if (GATE) { f32x4 g0, g1; unpack8(*(const u32x4*)(gate + off + bj * 128), g0, g1); v0 = v0 * g0; v1 = v1 * g1; }
                    if (ADD) { f32x4 a0, a1; unpack8(*(const u32x4*)(addsrc + off + bj * 128), a0, a1); v0 = v0 + a0; v1 = v1 + a1; }
                    *(u32x4*)(out + off + bj * 128) = pack8(v0, v1); } }
    }
};
struct EpiMerge {
    static constexpr bool PERM = true; static constexpr int NSTORES = 0;
    bf16_t* m1; bf16_t* out; const bf16_t* g0; const bf16_t* g1;
    __device__ __forceinline__ void operator()(const f32x4 (&acc)[2][2][4][2], const UnitG& u, int wr, int wc, int fr, int fq) const {
        asm volatile("" : "+v"(fr), "+v"(fq));
        const int row0 = u.x0 * 256 + wr * 64 + fr, col0 = u.x1 * 256 + wc * 32 + 8 * fq; const bool second = u.x2 != 0;
        const bf16_t* gate = second ? g1 : g0; bf16_t* dst = second ? out : m1;
#pragma unroll
        for (int ai = 0; ai < 2; ++ai)
#pragma unroll
            for (int m = 0; m < 4; ++m) { const size_t off = (size_t)(row0 + ai * 128 + m * 16) * D + col0;
#pragma unroll
                for (int bj = 0; bj < 2; ++bj) { f32x4 v0 = acc[ai][bj][m][0], v1 = acc[ai][bj][m][1];
                    f32x4 ga, gb; unpack8(*(const u32x4*)(gate + off + bj * 128), ga, gb); v0 = v0 * ga; v1 = v1 * gb;
                    if (second) { f32x4 a0, a1; unpack8(*(const u32x4*)(m1 + off + bj * 128), a0, a1); v0 = v0 + a0; v1 = v1 + a1; }
                    *(u32x4*)(dst + off + bj * 128) = pack8(v0, v1); } }
    }
};
struct EpiGU {
    static constexpr bool PERM = true; static constexpr int NSTORES = 0;
    const float* bg; const float* bu; const float* rs; unsigned char* actbase[2];
    __device__ __forceinline__ void operator()(const f32x4 (&acc)[2][2][4][2], const UnitG& u, int wr, int wc, int fr, int fq) const {
        asm volatile("" : "+v"(fr), "+v"(fq));
        const int tile = u.x0, e = u.x2, rl0 = u.x3, nval = u.x4;
        const int ff0 = u.x1 * 128 + wc * 32 + 8 * fq;
        const f32x4 bg0 = *(const f32x4*)(bg + e * D + ff0), bg1 = *(const f32x4*)(bg + e * D + ff0 + 4), bu0 = *(const f32x4*)(bu + e * D + ff0), bu1 = *(const f32x4*)(bu + e * D + ff0 + 4);
        unsigned char* abase = ((tile >> 9) == 0 ? actbase[0] : actbase[1]) + (size_t)(tile & 511) * (256 * D);
        const float* rsp = rs + (size_t)e * T + rl0;
        float rsv[8];
#pragma unroll
        for (int i = 0; i < 8; ++i) { const int r = (i >> 2) * 128 + wr * 64 + (i & 3) * 16 + fr; rsv[i] = (r < nval) ? rsp[r] * (1.0f / 32.0f) : 0.f; }
#pragma unroll
        for (int ai = 0; ai < 2; ++ai)
#pragma unroll
            for (int m = 0; m < 4; ++m) { const int r = ai * 128 + wr * 64 + m * 16 + fr;
                const float rstd = rsv[ai * 4 + m];
                f32x4 g0 = acc[ai][0][m][0] * rstd + bg0, g1 = acc[ai][0][m][1] * rstd + bg1, u0 = acc[ai][1][m][0] * rstd + bu0, u1 = acc[ai][1][m][1] * rstd + bu1;
#pragma unroll
                for (int j = 0; j < 4; ++j) {
                    { const float gm = fminf(g0[j], 7.0f), uc = fminf(fmaxf(u0[j], -7.0f), 7.0f); g0[j] = (4.0f * uc + 4.0f) * (gm * fast_rcp(1.0f + fast_exp2(gm * (-1.702f * LOG2E)))); }
                    { const float gm = fminf(g1[j], 7.0f), uc = fminf(fmaxf(u1[j], -7.0f), 7.0f); g1[j] = (4.0f * uc + 4.0f) * (gm * fast_rcp(1.0f + fast_exp2(gm * (-1.702f * LOG2E)))); } }
                u32x2 w; w.x = cvt4_fp8(g0[0], g0[1], g0[2], g0[3]); w.y = cvt4_fp8(g1[0], g1[1], g1[2], g1[3]);
                *(u32x2*)(abase + (size_t)r * D + ff0) = w; }
    }
};
struct EpiDown {
    static constexpr bool PERM = true; static constexpr int NSTORES = 16;
    const float* bd; const float* wt; const unsigned* list; unsigned char* ybase; unsigned char* junk;
    __device__ __forceinline__ void operator()(const f32x4 (&acc)[2][2][4][2], const UnitG& u, int wr, int wc, int fr, int fq) const {
        asm volatile("" : "+v"(fr), "+v"(fq));
        const int e = u.x2, rl0 = u.x3, nval = u.x4;
        const int c0 = u.x1 * 256 + wc * 32 + 8 * fq;
        f32x4 bv[2][2];
#pragma unroll
        for (int bj = 0; bj < 2; ++bj) { bv[bj][0] = *(const f32x4*)(bd + e * D + c0 + bj * 128); bv[bj][1] = *(const f32x4*)(bd + e * D + c0 + bj * 128 + 4); }
        const float* wtp = wt + (size_t)e * T + rl0; const unsigned* lp = list + (size_t)e * T + rl0;
        unsigned pr[8]; float wv[8];
#pragma unroll
        for (int i = 0; i < 8; ++i) { const int r = (i >> 2) * 128 + wr * 64 + (i & 3) * 16 + fr; const bool ok = r < nval; pr[i] = ok ? lp[r] : 0xffffffffu; wv[i] = ok ? wtp[r] : 0.f; }
#pragma unroll
        for (int ai = 0; ai < 2; ++ai)
#pragma unroll
            for (int m = 0; m < 4; ++m) { const unsigned pair = pr[ai * 4 + m]; const float w = wv[ai * 4 + m];
                {   const bool ok = pair != 0xffffffffu;
                    const unsigned yo = (ok ? pair * 2048u : 0u) + (unsigned)c0 * 2u;
                    unsigned char* yb_ = ok ? ybase : junk;
#pragma unroll
                    for (int bj = 0; bj < 2; ++bj) { const f32x4 v0 = (acc[ai][bj][m][0] * (1.0f / 128.0f) + bv[bj][0]) * w, v1 = (acc[ai][bj][m][1] * (1.0f / 128.0f) + bv[bj][1]) * w; __builtin_nontemporal_store(pack8(v0, v1), (u32x4*)(yb_ + yo + bj * 256)); } } }
    }
};
template <int NPN, bool GATHER> struct MoeSched {
    int G, c, ntl; const LAS int* ts; const LAS int* cn;
    const char* A; const unsigned* list; const char* W0; const char* W1; unsigned char* actbase[2];
    __device__ bool next(int i, UnitG& u) const {
        const int uu = i * G + c, xq = uu & 7, rk = uu >> 3, tile = xq + 8 * (rk / NPN), pn = rk % NPN;
        if (tile >= ntl) return false;
        int e = 0;
#pragma unroll
        for (int st = 16; st >= 1; st >>= 1) { if (ts[e + st] <= tile) e += st; }
        e = __builtin_amdgcn_readfirstlane(e);
        const int rl0 = __builtin_amdgcn_readfirstlane((tile - ts[e]) * 256), nval = __builtin_amdgcn_readfirstlane(cn[e]) - rl0;
        u.x0 = tile; u.x1 = pn; u.x2 = e; u.x3 = rl0; u.x4 = nval;
        if (GATHER) {
            u.A = A; u.B0 = W0 + ((size_t)e * 1024 + pn * 128) * 1024; u.B1 = W1 + ((size_t)e * 1024 + pn * 128) * 1024;
            int R, C; pg8::stage_rc((int)threadIdx.x * 16, R, C);
            unsigned tk[4];
#pragma unroll
            for (int j = 0; j < 4; ++j) { const int r = (j >> 1) * 128 + (j & 1) * 64 + R; tk[j] = (r < nval) ? (list[(size_t)e * T + rl0 + r] >> 2) : 0u; }
            u.tk0 = tk[0] | (tk[1] << 16); u.tk1 = tk[2] | (tk[3] << 16);
        } else {
            u.A = (const char*)(((tile >> 9) == 0 ? actbase[0] : actbase[1]) + (size_t)(tile & 511) * (256 * D)); u.B0 = W0 + ((size_t)e * 1024 + pn * 256) * 1024; u.B1 = u.B0 + (size_t)128 * 1024;
            u.tk0 = 0u; u.tk1 = 0u;
        }
        return true;
    }
    __device__ __forceinline__ void expand(const UnitG& u, unsigned& o0, unsigned& o1, unsigned& o2, unsigned& o3) const {
        int R, C0, C1; pg8::stage_rc((int)threadIdx.x * 16, R, C0); pg8::stage_rc((int)threadIdx.x * 16 + 8192, R, C1);
        if (GATHER) { o0 = (u.tk0 & 0xffffu) * 1024u + (unsigned)C0 * 2u; o1 = (u.tk0 >> 16) * 1024u + (unsigned)C1 * 2u; o2 = (u.tk1 & 0xffffu) * 1024u + (unsigned)C0 * 2u; o3 = (u.tk1 >> 16) * 1024u + (unsigned)C1 * 2u; }
        else { pg8::stage_rc((int)threadIdx.x * 16, R, C0); o0 = (unsigned)(R * 1024 + C0 * 2); o1 = (unsigned)((R + 64) * 1024 + C1 * 2); o2 = o0 + 128u * 1024u; o3 = o1 + 128u * 1024u;
               asm volatile("" : "+v"(o0), "+v"(o1), "+v"(o2), "+v"(o3)); }
    }
};
}

#define XB_TMO      128
#define XB_XCNT(j)  (256  + 64 * (j))
#define XB_XSUB(j)  (1280 + 64 * (j))
#define XB_XGEN(j)  (2304 + 64 * (j))
#define XB_TOP      3328
#define XB_TOPGEN   3392
#define XCD_BAR_WORDS 3456
#define XB_SPIN_CAP (1u << 18)
__device__ __forceinline__ unsigned xb_ld(unsigned* p)              { return __hip_atomic_load(p, __ATOMIC_RELAXED, __HIP_MEMORY_SCOPE_AGENT); }
__device__ __forceinline__ unsigned xb_add(unsigned* p, unsigned v) { return __hip_atomic_fetch_add(p, v, __ATOMIC_RELAXED, __HIP_MEMORY_SCOPE_AGENT); }
__device__ __forceinline__ unsigned xb_xcc_id() { return (unsigned)__builtin_amdgcn_s_getreg((3 << 11) | 20) & 0xFu; }
#define XB_SPIN(cond, bar) do { unsigned _sp = 0; while (cond) { __builtin_amdgcn_s_sleep(1); \
    if ((++_sp & 255u) == 0u) { if (xb_ld(&(bar)[XB_TMO])) break; if (_sp > XB_SPIN_CAP) { atomicAdd(&(bar)[XB_TMO], 1u); break; } } } } while (0)
struct XcdBarrier { unsigned* bar; unsigned x; volatile LAS unsigned* st; };
__device__ __forceinline__ XcdBarrier xcd_barrier_post(unsigned* bar, volatile LAS unsigned* st) {
    XcdBarrier b; b.bar = bar; b.x = xb_xcc_id(); b.st = st;
    if (threadIdx.x == 0) (void)xb_add(&bar[XB_XCNT(b.x)], 1u);
    return b;
}
__device__ __forceinline__ void xcd_barrier_complete(unsigned* bar, unsigned x, unsigned& nloc, unsigned& nx) {
    const unsigned G = gridDim.x * gridDim.y * gridDim.z;
    unsigned sum, cnt, mine, sp = 0u;
    for (;;) {
        sum = 0u; cnt = 0u; mine = 0u;
#pragma unroll
        for (unsigned j = 0; j < 16; ++j) { const unsigned c = xb_ld(&bar[XB_XCNT(j)]); sum += c; cnt += (c > 0u) ? 1u : 0u; mine = (j == x) ? c : mine; }
        if (sum == G) break;
        __builtin_amdgcn_s_sleep(1);
        if ((++sp & 255u) == 0u) { if (xb_ld(&bar[XB_TMO])) break; if (sp > XB_SPIN_CAP) { atomicAdd(&bar[XB_TMO], 1u); break; } }
    }
    nloc = mine > 0u ? mine : 1u; nx = cnt > 0u ? cnt : 1u;
}
__device__ __forceinline__ void xcd_barrier(const XcdBarrier& b) {
    asm volatile("s_waitcnt vmcnt(0)" ::: "memory");
    __syncthreads();
    if (threadIdx.x == 0) {
        unsigned* bar = b.bar;
        __builtin_amdgcn_s_waitcnt(0);
        unsigned nloc = b.st[0], nx = b.st[1];
        if (nloc == 0u) { xcd_barrier_complete(bar, b.x, nloc, nx); b.st[0] = nloc; b.st[1] = nx; }
        const unsigned old = xb_add(&bar[XB_XSUB(b.x)], 1u);
        const unsigned gen = old / nloc;
        if (old + 1u == (gen + 1u) * nloc) {
            __builtin_amdgcn_fence(__ATOMIC_RELEASE, "agent");
            asm volatile("s_waitcnt vmcnt(0)" ::: "memory");
            const unsigned og = xb_add(&bar[XB_TOP], 1u);
            const unsigned tg = og / nx;
            if (og + 1u == (tg + 1u) * nx) xb_add(&bar[XB_TOPGEN], 1u);
            else XB_SPIN(xb_ld(&bar[XB_TOPGEN]) == tg, bar);
            __builtin_amdgcn_fence(__ATOMIC_ACQUIRE, "agent");
            xb_add(&bar[XB_XGEN(b.x)], 1u);
            asm volatile("s_waitcnt vmcnt(0)" ::: "memory");
        } else {
            XB_SPIN(xb_ld(&bar[XB_XGEN(b.x)]) == gen, bar);
            __builtin_amdgcn_fence(__ATOMIC_ACQUIRE, "agent");
            asm volatile("s_waitcnt vmcnt(0)" ::: "memory");
        }
    }
    __syncthreads();
}

constexpr int NWAVES = 8, NTHREADS = 512;
struct Args { const float* in[29]; float* out; unsigned char* ws; int ph_lo, ph_hi, li, dbg; };
enum { I_X = 0, I_NMG, I_WIN, I_CONVW, I_CONVB, I_WRGA, I_BRGA, I_WRGX, I_BRGX, I_LAMBDA, I_DLQ1, I_DLK1, I_DLQ2, I_DLK2, I_SUBG, I_REL, I_WPRNN, I_WPATT, I_WOUT, I_NFG, I_WROUTER, I_BROUTER,
       I_WGATE, I_BGATE, I_WUP, I_BUP, I_WDOWN, I_BDOWN, I_NFINAL };

__device__ __forceinline__ void p0_transpose_item(const float* W, int K, int N, bf16_t* WT, int row_off, LAS float* scr, int item, int lane) {
    const int nblk = N / 32, kb = item / nblk, nb = item % nblk, k0 = 64 * kb, n0 = 32 * nb;
#pragma unroll 8
    for (int i = 0; i < 32; ++i) { const int kk = 2 * i + (lane >> 5); scr[kk * 33 + (lane & 31)] = W[(size_t)(k0 + kk) * N + n0 + (lane & 31)]; }
    LDS_WAIT(); asm volatile("" ::: "memory");
    const int c = lane & 7;
#pragma unroll
    for (int j = 0; j < 4; ++j) { const int n = (lane >> 3) + 8 * j; const LAS float* s = scr + (8 * c) * 33 + n;
        u32x4 o; o.x = cvtpk(s[0 * 33], s[1 * 33]); o.y = cvtpk(s[2 * 33], s[3 * 33]); o.z = cvtpk(s[4 * 33], s[5 * 33]); o.w = cvtpk(s[6 * 33], s[7 * 33]);
        *(u32x4*)((char*)WT + pg8::btile_off(row_off + n0 + n, (k0 + 8 * c) * 2, K / 64)) = o; }
    LDS_WAIT(); asm volatile("" ::: "memory");
}
__device__ __forceinline__ void p0_transpose_item_fp8(const float* W, int K, int N, unsigned char* WT, int row_off, LAS float* scr, int item, int lane, float scale) {
    const int nblk = N / 32, kb = item / nblk, nb = item % nblk, k0 = 64 * kb, n0 = 32 * nb;
    float wv_[32];
#pragma unroll
    for (int i = 0; i < 32; ++i) { const int kk = 2 * i + (lane >> 5); wv_[i] = W[(size_t)(k0 + kk) * N + n0 + (lane & 31)]; }
#pragma unroll
    for (int i = 0; i < 32; ++i) { const int kk = 2 * i + (lane >> 5); scr[kk * 33 + (lane & 31)] = wv_[i] * scale; }
    LDS_WAIT(); asm volatile("" ::: "memory");
    const int c = lane & 7;
#pragma unroll
    for (int j = 0; j < 4; ++j) { const int n = (lane >> 3) + 8 * j; const LAS float* s = scr + (8 * c) * 33 + n;
        u32x2 o; o.x = cvt4_fp8(s[0 * 33], s[1 * 33], s[2 * 33], s[3 * 33]); o.y = cvt4_fp8(s[4 * 33], s[5 * 33], s[6 * 33], s[7 * 33]);
        *(u32x2*)(WT + pg8::btile_off(row_off + n0 + n, k0 + 8 * c, K / 128)) = o; }
    LDS_WAIT(); asm volatile("" ::: "memory");
}
__device__ __forceinline__ void rms_row_to_bf16(const float* xrow, bf16_t* orow, unsigned char* orow8, const f32x4 (&g)[4], int lane) {
    const f32x4* xr = (const f32x4*)xrow + lane;
    f32x4 v[4]; float s = 0.f;
#pragma unroll
    for (int j = 0; j < 4; ++j) { v[j] = xr[64 * j]; s += (v[j].x * v[j].x + v[j].y * v[j].y) + (v[j].z * v[j].z + v[j].w * v[j].w); }
    const float rstd = 1.0f / sqrtf(wave_sum(s) * (1.f / D) + EPS);
    u32x2* o8 = (u32x2*)orow + lane;
#pragma unroll
    for (int j = 0; j < 4; ++j) { const f32x4 y = v[j] * rstd * g[j]; u32x2 w; w.x = cvtpk(y.x, y.y); w.y = cvtpk(y.z, y.w); o8[64 * j] = w;
        ((unsigned*)orow8 + lane)[64 * j] = cvt4_fp8(y.x, y.y, y.z, y.w); }
}
__device__ __forceinline__ int rel_bucket_dev(int n) {
    if (n < 16) return n;
    const float v = logf((float)n / 16.0f) / logf(8.0f) * 16.0f; int b = 16 + (int)v; return b < 31 ? b : 31;
}

#define LB() asm volatile("s_waitcnt lgkmcnt(0)\n\ts_barrier" ::: "memory")
namespace rglru {
constexpr int TL = 128, PITCH = 144;
constexpr int WV = 9728;
constexpr int W_XR = 0, W_GR = 2816, W_XC = 5120;
constexpr int L_AGG = 8 * WV  , L_CW = L_AGG + 8192  , L_WF = L_CW + 1536  ;
struct Tensors { const bf16_t* xr; const bf16_t* gr; bf16_t* y; const float* conv_w; const float* conv_b; const float* w_a; const float* b_a; const float* w_x; const float* b_x; const float* sp; };

__device__ __forceinline__ void unit(LAS unsigned char* lds, const Tensors& P, int b, int n) {
    const int tid = threadIdx.x, lane = tid & 63, wid = __builtin_amdgcn_readfirstlane(tid >> 6), l16 = lane & 15, q4 = lane >> 4;
    LAS unsigned char* wl = lds + wid * WV;
    LB();
    if (tid < 320) { const int j = tid >> 6, c = tid & 63; ((LAS float*)(lds + L_CW))[tid] = (j < 4) ? P.conv_w[j * D + n * 64 + c] : P.conv_b[n * 64 + c]; }
#pragma unroll 1
    for (int f = wid; f < 16; f += 8) { const int g = f >> 3, db = (f >> 1) & 3, ks = f & 1; const float* W = (g == 0 ? P.w_a : P.w_x) + (size_t)n * 64 * 64; float v[8];
#pragma unroll
        for (int j = 0; j < 8; ++j) v[j] = W[(32 * ks + 8 * q4 + j) * 64 + 16 * db + l16];
        u32x4 w; w.x = cvtpk(v[0], v[1]); w.y = cvtpk(v[2], v[3]); w.z = cvtpk(v[4], v[5]); w.w = cvtpk(v[6], v[7]); *(LAS u32x4*)(lds + L_WF + (f * 64 + lane) * 16) = w; }
    const int sh16 = ((lane - 16) & 63) * 4, sh32 = ((lane - 32) & 63) * 4;
#define RG_UP(v, sh) __int_as_float(__builtin_amdgcn_ds_bpermute(sh, __float_as_int(v)))
    float ba[4], bx[4], sp[4], hin[4];
#pragma unroll
    for (int db = 0; db < 4; ++db) { const int d = n * 64 + 16 * db + l16; ba[db] = P.b_a[d]; bx[db] = P.b_x[d]; sp[db] = P.sp[d] * (-8.0f * LOG2E); hin[db] = 0.f; }
    const size_t rowb = (size_t)b * SEQ;
    const bf16_t* xg = P.xr + n * 64; const bf16_t* gg = P.gr + n * 64; bf16_t* yg = P.y + n * 64;
    u32x4 pxr[3], pgr[2];
    const u32x4 z4 = {0u, 0u, 0u, 0u};
#define RG_LOAD(t0) do { const int tb_ = (t0) + 16 * wid; \
        _Pragma("unroll") for (int i = 0; i < 3; ++i) { const int cid = lane + 64 * i, row = cid >> 3, ch = cid & 7, tm = tb_ - 3 + row; \
            pxr[i] = (cid < 152 && tm >= 0) ? *(const u32x4*)(xg + (rowb + tm) * D + ch * 8) : z4; } \
        _Pragma("unroll") for (int i = 0; i < 2; ++i) { const int cid = lane + 64 * i, row = cid >> 3, ch = cid & 7; \
            pgr[i] = *(const u32x4*)(gg + (rowb + tb_ + row) * D + ch * 8); } } while (0)
    RG_LOAD(0);
    LB();
    for (int tile = 0; tile < SEQ / TL; ++tile) {
        const int t0 = tile * TL;
#pragma unroll
        for (int i = 0; i < 3; ++i) { const int cid = lane + 64 * i, row = cid >> 3, ch = cid & 7; if (cid < 152) *(LAS u32x4*)(wl + W_XR + row * PITCH + ch * 16) = pxr[i]; }
#pragma unroll
        for (int i = 0; i < 2; ++i) { const int cid = lane + 64 * i, row = cid >> 3, ch = cid & 7; *(LAS u32x4*)(wl + W_GR + row * PITCH + ch * 16) = pgr[i]; }
        LDS_WAIT();
        if (tile + 1 < SEQ / TL) RG_LOAD(t0 + TL);
        bf16x8 af[2];
#pragma unroll
        for (int ks = 0; ks < 2; ++ks) { const int c0 = 32 * ks + 8 * q4;
            const LAS float* cw = (const LAS float*)(lds + L_CW);
            f32x4 s0 = *(const LAS f32x4*)(cw + 256 + c0), s1 = *(const LAS f32x4*)(cw + 256 + c0 + 4);
#pragma unroll
            for (int jj = 0; jj < 4; ++jj) { const u32x4 xv = *(const LAS u32x4*)(wl + W_XR + (l16 + jj) * PITCH + c0 * 2);
                const f32x4 w0 = *(const LAS f32x4*)(cw + jj * 64 + c0), w1 = *(const LAS f32x4*)(cw + jj * 64 + c0 + 4);
                s0 += w0 * (f32x4){bflo(xv.x), bfhi(xv.x), bflo(xv.y), bfhi(xv.y)}; s1 += w1 * (f32x4){bflo(xv.z), bfhi(xv.z), bflo(xv.w), bfhi(xv.w)}; }
            *(LAS f32x4*)(wl + W_XC + (l16 * 68 + c0) * 4) = s0; *(LAS f32x4*)(wl + W_XC + (l16 * 68 + c0 + 4) * 4) = s1;
            u32x4 w; w.x = cvtpk(s0[0], s0[1]); w.y = cvtpk(s0[2], s0[3]); w.z = cvtpk(s1[0], s1[1]); w.w = cvtpk(s1[2], s1[3]); af[ks] = __builtin_bit_cast(bf16x8, w); }
        f32x4 ra[4], rx[4];
#pragma unroll
        for (int db = 0; db < 4; ++db) { ra[db] = (f32x4){0.f, 0.f, 0.f, 0.f}; rx[db] = ra[db];
#pragma unroll
            for (int ks = 0; ks < 2; ++ks) { const bf16x8 wa = *(const LAS bf16x8*)(lds + L_WF + (((0 * 4 + db) * 2 + ks) * 64 + lane) * 16), wx = *(const LAS bf16x8*)(lds + L_WF + (((1 * 4 + db) * 2 + ks) * 64 + lane) * 16);
                ra[db] = __builtin_amdgcn_mfma_f32_16x16x32_bf16(af[ks], wa, ra[db], 0, 0, 0); rx[db] = __builtin_amdgcn_mfma_f32_16x16x32_bf16(af[ks], wx, rx[db], 0, 0, 0); } }
        LDS_WAIT();
        float av[4][4], uv[4][4], gl[4][4], EA[4], EH[4];
        const int tc = 4 * q4;
        LAS unsigned char* agg = lds + L_AGG + (tile & 1) * 4096;
#pragma unroll
        for (int db = 0; db < 4; ++db) { const int d = 16 * db + l16;
#pragma unroll
            for (int j = 0; j < 4; ++j) {
                const float xc = *(const LAS float*)(wl + W_XC + ((tc + j) * 68 + d) * 4);
                const float g = bf2f(*(const LAS unsigned short*)(wl + W_GR + (tc + j) * PITCH + d * 2));
                const float r = sigmoidf_(ra[db][j] + ba[db]), ig = sigmoidf_(rx[db][j] + bx[db]);
                const float a = fast_exp2(r * sp[db]);
                av[db][j] = a; uv[db][j] = __builtin_amdgcn_sqrtf(fmaxf(1.0f - a * a, 0.f)) * (ig * xc);
                gl[db][j] = g * fast_rcp(1.0f + fast_exp2(g * ((-2.0f * 0.7978845608028654f * LOG2E) + (-2.0f * 0.7978845608028654f * LOG2E * 0.044715f) * (g * g))));
            }
            float a_ = av[db][0] * av[db][1] * av[db][2] * av[db][3];
            float h_ = ((uv[db][0] * av[db][1] + uv[db][1]) * av[db][2] + uv[db][2]) * av[db][3] + uv[db][3];
            float pa = RG_UP(a_, sh16), ph = RG_UP(h_, sh16);
            if (q4 >= 1) { h_ = ph * a_ + h_; a_ = pa * a_; }
            pa = RG_UP(a_, sh32); ph = RG_UP(h_, sh32);
            if (q4 >= 2) { h_ = ph * a_ + h_; a_ = pa * a_; }
            EA[db] = RG_UP(a_, sh16); EH[db] = RG_UP(h_, sh16);
            if (q4 == 3) { *(LAS f32x2*)(agg + ((wid * 64 + d) * 2) * 4) = (f32x2){a_, h_}; }
        }
        LB();
#pragma unroll
        for (int db = 0; db < 4; ++db) { const int d = 16 * db + l16;
            float hw = hin[db], hall = hin[db];
#pragma unroll
            for (int w2 = 0; w2 < 8; ++w2) { const f32x2 ag = *(const LAS f32x2*)(agg + ((w2 * 64 + d) * 2) * 4); hall = ag.x * hall + ag.y; if (w2 < wid) hw = hall; }
            hin[db] = hall;
            float h = (q4 == 0) ? hw : (EA[db] * hw + EH[db]);
#pragma unroll
            for (int j = 0; j < 4; ++j) { h = av[db][j] * h + uv[db][j];
                const unsigned yb = cvtpk(h * gl[db][j], 0.f);
                *(LAS unsigned short*)(wl + W_GR + (tc + j) * PITCH + d * 2) = (unsigned short)(yb & 0xffffu); }
        }
        LDS_WAIT();
#pragma unroll
        for (int i = 0; i < 2; ++i) { const int cid = lane + 64 * i, row = cid >> 3, ch = cid & 7;
            *(u32x4*)(yg + (rowb + t0 + 16 * wid + row) * D + ch * 8) = *(const LAS u32x4*)(wl + W_GR + row * PITCH + ch * 16); }
        LDS_WAIT();
    }
#undef RG_LOAD
#undef RG_UP
    LB();
}
}

namespace att {
constexpr int STG = 32768;
constexpr int NSTG = 4;
constexpr int L_WS = LDSCTL_OFF + 1024  , L_BT = LDSCTL_OFF + 3072  , L_OS = 65536  , L_X = 0  ;
constexpr int OSP = 272;
constexpr float THR = 8.0f;
struct Tensors { const bf16_t* Q; const bf16_t* K; const bf16_t* V; bf16_t* Y; const float* bt; const float* subg; const float* lam; const float* km2; const float* bmax; };
__device__ __forceinline__ int crow(int r, int hi) { return (r & 3) + 8 * (r >> 2) + 4 * hi; }
typedef short v4i16_t __attribute__((ext_vector_type(4)));
#define VTR_ISSUE(dst, p, off) asm volatile("ds_read_b64_tr_b16 %0, %1 offset:%2" : "=v"(dst) : "v"(p), "i"(off))
#define VFR_ISSUE(j, vp_) do { VTR_ISSUE(vl_[j], vp_, ((j) & 3) * 4096 + ((j) >> 2) * 1024); VTR_ISSUE(vh_[j], vp_, ((j) & 3) * 4096 + ((j) >> 2) * 1024 + 512); } while (0)
#define VFR_WAITN(n, j) asm volatile("s_waitcnt lgkmcnt(" #n ")" : "+v"(vl_[j]), "+v"(vh_[j]))
#define VFR_WAIT(j) do { if ((j) <= 11) VFR_WAITN(8, j); else if ((j) == 12) VFR_WAITN(6, j); else if ((j) == 13) VFR_WAITN(4, j); else if ((j) == 14) VFR_WAITN(2, j); else VFR_WAITN(0, j); } while (0)
#define VFR_GET(j) ((bf16x8){vl_[j][0], vl_[j][1], vl_[j][2], vl_[j][3], vh_[j][0], vh_[j][1], vh_[j][2], vh_[j][3]})
__device__ __forceinline__ float max3f(float a, float b, float c) { return __builtin_fmaxf(__builtin_fmaxf(a, b), c); }
__device__ __forceinline__ float swapmax(float m) { auto rr = __builtin_amdgcn_permlane32_swap(__float_as_uint(m), __float_as_uint(m), false, false); return fmaxf(__uint_as_float(rr[0]), __uint_as_float(rr[1])); }
__device__ __forceinline__ float swapsum(float m) { auto rr = __builtin_amdgcn_permlane32_swap(__float_as_uint(m), __float_as_uint(m), false, false); return __uint_as_float(rr[0]) + __uint_as_float(rr[1]); }

#define ATT_PK(P, B) cvtpk(P[B], P[(B) + 1])
template <class QP> __device__ __forceinline__ void unit(LAS unsigned char* lds, const Tensors& P, int& item, int& rot, bool& pre, unsigned& popv, float& btp, bf16x8 (&qr)[4], const int qlo, const int qhi, QP qctr) {
    const int tid = threadIdx.x, lane = tid & 63, r32 = lane & 31, hi = lane >> 5, wid = __builtin_amdgcn_readfirstlane(tid >> 6), map = wid >> 2, qs = wid & 3;
    const int j_ = item - 128, qb = 31 - (j_ >> 6), b = (j_ & 63) >> 3, h = j_ & 7;
    LAS unsigned* lwq = (LAS unsigned*)(lds + LDSCTL_OFF) + LW_Q;
#define STGOF(t) ((((t) + rot) & 3) * STG)
    const size_t rowb = (size_t)b * SEQ; const int q0 = qb * 128, qw0 = q0 + 32 * qs, NTL = 2 * qb + 2;
    LAS float* wsf = (LAS float*)(lds + L_WS) + wid * 64;
    if (tid < 128) ((LAS float*)(lds + L_BT))[tid] = pre ? btp : P.bt[h * 128 + tid] - P.bt[h * 128 + 127];
    const bf16_t* ks1 = P.K + ((size_t)((b * 8 + h) * 2) * 64) * 4096 + wid * 512 + lane * 8;
    const bf16_t* ks2 = ks1 + (size_t)64 * 4096;
    const bf16_t* vsa = P.V + ((size_t)(b * 8 + h) * 64) * 8192 + wid * 512 + lane * 8;
    const bf16_t* vsb = vsa + 8 * 512;
    const int dk1 = wid * 1024, dk2 = 8192 + wid * 1024, dva = 16384 + wid * 1024, dvb = 16384 + (wid + 8) * 1024;
#define ATT_DMA(t, st) do { const size_t gk = (size_t)(t) * 4096, gv = (size_t)(t) * 8192; \
        __builtin_amdgcn_global_load_lds((const GAS unsigned*)(ks1 + gk), (LAS unsigned*)(lds + (st) + dk1), 16, 0, 0); \
        __builtin_amdgcn_global_load_lds((const GAS unsigned*)(ks2 + gk), (LAS unsigned*)(lds + (st) + dk2), 16, 0, 0); \
        __builtin_amdgcn_global_load_lds((const GAS unsigned*)(vsa + gv), (LAS unsigned*)(lds + (st) + dva), 16, 0, 0); \
        __builtin_amdgcn_global_load_lds((const GAS unsigned*)(vsb + gv), (LAS unsigned*)(lds + (st) + dvb), 16, 0, 0); } while (0)
    if (!pre) {
        ATT_DMA(0, STGOF(0));
        ATT_DMA(1, STGOF(1));
#pragma unroll
        for (int d0 = 0; d0 < 4; ++d0) qr[d0] = *(const bf16x8*)(P.Q + (rowb + qw0 + r32) * D + h * 128 + map * 64 + d0 * 16 + hi * 8);
    }
    float mref = 0.f, lsum = 0.f;
    f32x16 o[4]; const f32x16 zero16 = {0.f, 0.f, 0.f, 0.f, 0.f, 0.f, 0.f, 0.f, 0.f, 0.f, 0.f, 0.f, 0.f, 0.f, 0.f, 0.f};
#pragma unroll
    for (int r = 0; r < 16; ++r) { o[0][r] = 0.f; o[1][r] = 0.f; o[2][r] = 0.f; o[3][r] = 0.f; }
    const LAS unsigned char* kb0 = lds + map * 8192 + hi * 1024 + r32 * 16;
    const LAS unsigned char* vp0 = lds + 16384 + ((lane >> 4) & 1) * 32 + (lane & 3) * 8 + (4 * hi + ((lane & 15) >> 2)) * 64;
    const LAS float* btl = (const LAS float*)(lds + L_BT);
    f32x16 pA0, pA1, pB0, pB1; u32x4 pw0, pw1, pw2, pw3; bool resc = false;
#define KFR(kb_, i) (*(const LAS bf16x8*)((kb_) + ((i) >> 1) * 2048 + ((i) & 1) * 512))
#define ATT_DECIDE(C0, C1, t, FAST) do { const int k0_ = 64 * (t); \
        if (!(FAST) && __any(mref != 0.f)) { _Pragma("unroll") for (int r = 0; r < 16; ++r) { C0[r] -= mref; C1[r] -= mref; } } \
        if ((qw0 - (k0_ + 63)) < 113) { const int base_ = qw0 + r32 - k0_ - 4 * hi; \
            _Pragma("unroll") for (int r = 0; r < 16; ++r) { const int d0_ = base_ - ((r & 3) + 8 * (r >> 2)), d1_ = d0_ - 32; \
                const float b0_ = btl[min(max(d0_, 0), 127)], b1_ = btl[min(max(d1_, 0), 127)]; \
                C0[r] = (d0_ < 0) ? -INFINITY : C0[r] + b0_; C1[r] = (d1_ < 0) ? -INFINITY : C1[r] + b1_; if ((r & 3) == 3) SBAR(); } } \
        if (!(FAST)) { \
        float rm_ = max3f(C0[0], C0[1], C1[0]), rn_ = max3f(C0[2], C0[3], C1[1]); rm_ = max3f(rm_, C1[2], C1[3]); \
        _Pragma("unroll") for (int r = 4; r < 16; r += 4) { rm_ = max3f(rm_, C0[r], C0[r + 1]); rn_ = max3f(rn_, C0[r + 2], C0[r + 3]); rm_ = max3f(rm_, C1[r], C1[r + 1]); rn_ = max3f(rn_, C1[r + 2], C1[r + 3]); } \
        rm_ = swapmax(max3f(rm_, rn_, rn_)); \
        const bool first_ = ((t) == 0);                                    \
        resc = __any(rm_ > THR || (first_ && rm_ < -THR)); \
        if (resc) { const float dl_ = first_ ? rm_ : fmaxf(rm_, 0.f); mref += dl_; \
            _Pragma("unroll") for (int r = 0; r < 16; ++r) { C0[r] -= dl_; C1[r] -= dl_; } \
            const float f_ = first_ ? 1.0f : fast_exp2(-dl_); lsum *= f_; if (hi == 0) wsf[r32] = f_; } } } while (0)
#define ATT_RESC(FAST) do { if (!(FAST) && resc) { LDS_WAIT(); \
        _Pragma("unroll") for (int r = 0; r < 16; ++r) { const float f_ = wsf[crow(r, hi)]; o[0][r] *= f_; o[1][r] *= f_; o[2][r] *= f_; o[3][r] *= f_; } } } while (0)
#define ATT_GA(CX, KF, D0, FIRST, a0, a1, a2, a3, PWX, PSRC, PB0) do { \
        CX = __builtin_amdgcn_mfma_f32_32x32x16_bf16(KF, qr[D0], (FIRST) ? negm : CX, 0, 0, 0); \
        sacc += (a0 + a1) + (a2 + a3); PWX = ATT_PK(PSRC, PB0); } while (0)
#define ATT_STEP(C0, C1, P0, P1, t, FAST) do { \
        const LAS unsigned char* kb_ = kb0 + STGOF(t); const LAS unsigned char* vp_ = vp0 + STGOF((t) + 3); \
        bf16x8 ka_ = KFR(kb_, 0), kc_ = KFR(kb_, 1); float sacc = 0.f; s16x4 vl_[16], vh_[16]; \
        SBAR(); \
        C0 = __builtin_amdgcn_mfma_f32_32x32x16_bf16(ka_, qr[0], zero16, 0, 0, 0); ka_ = KFR(kb_, 2); sacc += (P0[0] + P0[1]) + (P0[2] + P0[3]); pw0.x = ATT_PK(P0, 0); pw0.y = ATT_PK(P0, 2); asm volatile("" : "+v"(sacc)); asm volatile("" : "+v"(pw0)); SBAR(); \
        C1 = __builtin_amdgcn_mfma_f32_32x32x16_bf16(kc_, qr[0], zero16, 0, 0, 0); kc_ = KFR(kb_, 3); sacc += (P0[4] + P0[5]) + (P0[6] + P0[7]); pw0.z = ATT_PK(P0, 4); pw0.w = ATT_PK(P0, 6); asm volatile("" : "+v"(sacc)); asm volatile("" : "+v"(pw0)); SBAR(); \
        C0 = __builtin_amdgcn_mfma_f32_32x32x16_bf16(ka_, qr[1], C0, 0, 0, 0); ka_ = KFR(kb_, 4); sacc += (P0[8] + P0[9]) + (P0[10] + P0[11]); pw1.x = ATT_PK(P0, 8); pw1.y = ATT_PK(P0, 10); asm volatile("" : "+v"(sacc)); asm volatile("" : "+v"(pw1)); SBAR(); \
        C1 = __builtin_amdgcn_mfma_f32_32x32x16_bf16(kc_, qr[1], C1, 0, 0, 0); kc_ = KFR(kb_, 5); sacc += (P0[12] + P0[13]) + (P0[14] + P0[15]); pw1.z = ATT_PK(P0, 12); pw1.w = ATT_PK(P0, 14); asm volatile("" : "+v"(sacc)); asm volatile("" : "+v"(pw1)); SBAR(); \
        C0 = __builtin_amdgcn_mfma_f32_32x32x16_bf16(ka_, qr[2], C0, 0, 0, 0); ka_ = KFR(kb_, 6); sacc += (P1[0] + P1[1]) + (P1[2] + P1[3]); pw2.x = ATT_PK(P1, 0); pw2.y = ATT_PK(P1, 2); asm volatile("" : "+v"(sacc)); asm volatile("" : "+v"(pw2)); SBAR(); \
        C1 = __builtin_amdgcn_mfma_f32_32x32x16_bf16(kc_, qr[2], C1, 0, 0, 0); kc_ = KFR(kb_, 7); sacc += (P1[4] + P1[5]) + (P1[6] + P1[7]); pw2.z = ATT_PK(P1, 4); pw2.w = ATT_PK(P1, 6); asm volatile("" : "+v"(sacc)); asm volatile("" : "+v"(pw2)); SBAR(); \
        C0 = __builtin_amdgcn_mfma_f32_32x32x16_bf16(ka_, qr[3], C0, 0, 0, 0); VFR_ISSUE(0, vp_); VFR_ISSUE(1, vp_); sacc += (P1[8] + P1[9]) + (P1[10] + P1[11]); pw3.x = ATT_PK(P1, 8); pw3.y = ATT_PK(P1, 10); asm volatile("" : "+v"(sacc)); asm volatile("" : "+v"(pw3)); SBAR(); \
        C1 = __builtin_amdgcn_mfma_f32_32x32x16_bf16(kc_, qr[3], C1, 0, 0, 0); VFR_ISSUE(2, vp_); VFR_ISSUE(3, vp_); sacc += (P1[12] + P1[13]) + (P1[14] + P1[15]); pw3.z = ATT_PK(P1, 12); pw3.w = ATT_PK(P1, 14); asm volatile("" : "+v"(sacc)); asm volatile("" : "+v"(pw3)); SBAR(); \
        lsum += sacc; \
        ATT_DECIDE(C0, C1, t, FAST); SBAR(); \
        _Pragma("unroll") for (int j = 0; j < 16; ++j) { \
            if (j + 4 < 16) VFR_ISSUE(j + 4, vp_); \
            VFR_WAIT(j); \
            const u32x4 pwj_ = (j >> 2) == 0 ? pw0 : (j >> 2) == 1 ? pw1 : (j >> 2) == 2 ? pw2 : pw3; \
            o[j & 3] = __builtin_amdgcn_mfma_f32_32x32x16_bf16(__builtin_bit_cast(bf16x8, pwj_), VFR_GET(j), o[j & 3], 0, 0, 0); \
            if (j < 8) { C0[2 * j] = fast_exp2(C0[2 * j]); C0[2 * j + 1] = fast_exp2(C0[2 * j + 1]); asm volatile("" : "+v"(C0)); } else { C1[2 * j - 16] = fast_exp2(C1[2 * j - 16]); C1[2 * j - 15] = fast_exp2(C1[2 * j - 15]); asm volatile("" : "+v"(C1)); } \
            SBAR(); } \
        ATT_RESC(FAST); } while (0)
#define ATT_TOP(t) do { if ((t) + 1 < NTL) asm volatile("s_waitcnt vmcnt(4) lgkmcnt(0)\n\ts_barrier" ::: "memory"); else WG_BAR(); \
        if ((t) == 0 && pre && tid == 0) lwq[0] = popv;                      \
        if ((t) + 2 < NTL) ATT_DMA((t) + 2, STGOF((t) + 2)); } while (0)
#define ATT_DRAIN(P0, P1, vp_) do { float sacc = 0.f; \
        _Pragma("unroll") for (int r = 0; r < 16; ++r) sacc += P0[r] + P1[r]; \
        lsum += sacc; \
        pw0 = (u32x4){ATT_PK(P0, 0), ATT_PK(P0, 2), ATT_PK(P0, 4), ATT_PK(P0, 6)}; pw1 = (u32x4){ATT_PK(P0, 8), ATT_PK(P0, 10), ATT_PK(P0, 12), ATT_PK(P0, 14)}; \
        pw2 = (u32x4){ATT_PK(P1, 0), ATT_PK(P1, 2), ATT_PK(P1, 4), ATT_PK(P1, 6)}; pw3 = (u32x4){ATT_PK(P1, 8), ATT_PK(P1, 10), ATT_PK(P1, 12), ATT_PK(P1, 14)}; \
        s16x4 vl_[16], vh_[16]; VFR_ISSUE(0, vp_); VFR_ISSUE(1, vp_); VFR_ISSUE(2, vp_); VFR_ISSUE(3, vp_); \
        _Pragma("unroll") for (int j = 0; j < 16; ++j) { if (j + 4 < 16) VFR_ISSUE(j + 4, vp_); \
            VFR_WAIT(j); \
            const u32x4 pwj_ = (j >> 2) == 0 ? pw0 : (j >> 2) == 1 ? pw1 : (j >> 2) == 2 ? pw2 : pw3; \
            o[j & 3] = __builtin_amdgcn_mfma_f32_32x32x16_bf16(__builtin_bit_cast(bf16x8, pwj_), VFR_GET(j), o[j & 3], 0, 0, 0); } } while (0)
    bool fast;
    {   float qn = 0.f;
#pragma unroll
        for (int d0 = 0; d0 < 4; ++d0) { const u32x4 w = __builtin_bit_cast(u32x4, qr[d0]); const float a0 = bflo(w.x), a1 = bfhi(w.x), a2 = bflo(w.y), a3 = bfhi(w.y), a4 = bflo(w.z), a5 = bfhi(w.z), a6 = bflo(w.w), a7 = bfhi(w.w);
            qn += (a0 * a0 + a1 * a1) + (a2 * a2 + a3 * a3) + (a4 * a4 + a5 * a5) + (a6 * a6 + a7 * a7); }
        qn = swapsum(qn);
        const float km2 = (P.km2[((b * 8 + h) * 2 + map) * 2] + P.km2[((b * 8 + h) * 2 + map) * 2 + 1]) * 1.05f;
        const float bound = sqrtf(qn * km2) + P.bmax[h];
        fast = !__any(!(bound < 96.0f));
    }
#define ATT_WALK(FAST) do { \
    ATT_TOP(0); \
    { const LAS unsigned char* kbf_ = kb0 + STGOF(0); _Pragma("unroll") for (int d0 = 0; d0 < 4; ++d0) { const bf16x8 k0_ = KFR(kbf_, 2 * d0), k1_ = KFR(kbf_, 2 * d0 + 1); \
            pA0 = __builtin_amdgcn_mfma_f32_32x32x16_bf16(k0_, qr[d0], d0 == 0 ? zero16 : pA0, 0, 0, 0); pA1 = __builtin_amdgcn_mfma_f32_32x32x16_bf16(k1_, qr[d0], d0 == 0 ? zero16 : pA1, 0, 0, 0); } \
        ATT_DECIDE(pA0, pA1, 0, FAST); \
        _Pragma("unroll") for (int r = 0; r < 16; ++r) { pA0[r] = fast_exp2(pA0[r]); pA1[r] = fast_exp2(pA1[r]); } \
        ATT_RESC(FAST); } \
    int t = 1; \
    _Pragma("unroll 1") for (; t + 1 < NTL; t += 2) { \
        ATT_TOP(t); ATT_STEP(pB0, pB1, pA0, pA1, t, FAST); \
        ATT_TOP(t + 1); ATT_STEP(pA0, pA1, pB0, pB1, t + 1, FAST); } \
    ATT_TOP(t); ATT_STEP(pB0, pB1, pA0, pA1, t, FAST); \
    { const LAS unsigned char* vpl = vp0 + STGOF(NTL - 1); ATT_DRAIN(pB0, pB1, vpl); } } while (0)
    if (fast) ATT_WALK(1);
    else {
#pragma unroll 1
        for (int t = 0; t < NTL; ++t) {
            ATT_TOP(t);
            const LAS unsigned char* kb_ = kb0 + STGOF(t); const LAS unsigned char* vp_ = vp0 + STGOF(t);
#pragma unroll
            for (int d0 = 0; d0 < 4; ++d0) { const bf16x8 k0_ = KFR(kb_, 2 * d0), k1_ = KFR(kb_, 2 * d0 + 1);
                pA0 = __builtin_amdgcn_mfma_f32_32x32x16_bf16(k0_, qr[d0], d0 == 0 ? zero16 : pA0, 0, 0, 0); pA1 = __builtin_amdgcn_mfma_f32_32x32x16_bf16(k1_, qr[d0], d0 == 0 ? zero16 : pA1, 0, 0, 0); }
            ATT_DECIDE(pA0, pA1, t, 0);
            ATT_RESC(0);
            float sacc = 0.f;
#pragma unroll
            for (int r = 0; r < 16; ++r) { pA0[r] = fast_exp2(pA0[r]); pA1[r] = fast_exp2(pA1[r]); sacc += pA0[r] + pA1[r]; }
            lsum += sacc;
            pw0 = (u32x4){ATT_PK(pA0, 0), ATT_PK(pA0, 2), ATT_PK(pA0, 4), ATT_PK(pA0, 6)}; pw1 = (u32x4){ATT_PK(pA0, 8), ATT_PK(pA0, 10), ATT_PK(pA0, 12), ATT_PK(pA0, 14)};
            pw2 = (u32x4){ATT_PK(pA1, 0), ATT_PK(pA1, 2), ATT_PK(pA1, 4), ATT_PK(pA1, 6)}; pw3 = (u32x4){ATT_PK(pA1, 8), ATT_PK(pA1, 10), ATT_PK(pA1, 12), ATT_PK(pA1, 14)};
            s16x4 vl_[16], vh_[16];
#pragma unroll
            for (int j = 0; j < 16; ++j) { if (j == 0) { VFR_ISSUE(0, vp_); VFR_ISSUE(1, vp_); VFR_ISSUE(2, vp_); VFR_ISSUE(3, vp_); }
                if (j + 4 < 16) VFR_ISSUE(j + 4, vp_);
                VFR_WAIT(j);
                const u32x4 pwj_ = (j >> 2) == 0 ? pw0 : (j >> 2) == 1 ? pw1 : (j >> 2) == 2 ? pw2 : pw3;
                o[j & 3] = __builtin_amdgcn_mfma_f32_32x32x16_bf16(__builtin_bit_cast(bf16x8, pwj_), VFR_GET(j), o[j & 3], 0, 0, 0); }
        }
    }
#undef ATT_WALK
#undef ATT_TOP
#undef ATT_DMA
#undef ATT_DRAIN
#undef ATT_STEP
#undef ATT_GA
#undef ATT_DECIDE
#undef ATT_RESC
#undef KFR
#undef VFR_ISSUE
#undef VFR_WAIT
#undef VFR_WAITN
#undef VFR_GET
#undef VTR_ISSUE
    int lane_e = lane; asm volatile("" : "+v"(lane_e));
    const int r32e = lane_e & 31, hie = lane_e >> 5;
    LAS float* wsfe = (LAS float*)(lds + L_WS) + wid * 64;
    lsum = swapsum(lsum);
    if (hie == 0) wsfe[32 + r32e] = lsum;
    LDS_WAIT();
#pragma unroll
    for (int r = 0; r < 16; ++r) { const float rl = fast_rcp(wsfe[32 + crow(r, hie)]);
#pragma unroll
        for (int db = 0; db < 4; ++db) o[db][r] *= rl; }
    WG_BAR();
    const int nxt = __builtin_amdgcn_readfirstlane((int)lwq[0]) + qlo, rotn = (NTL + rot) & 3;
    if (nxt < qhi) {
        const int jn = nxt - 128, qbn = 31 - (jn >> 6), bn = (jn & 63) >> 3, hn = jn & 7, widn = lane_e >> 6 ? 0 : wid;
        const bf16_t* k1n = P.K + ((size_t)((bn * 8 + hn) * 2) * 64) * 4096 + widn * 512 + lane_e * 8; const bf16_t* k2n = k1n + (size_t)64 * 4096;
        const bf16_t* van = P.V + ((size_t)(bn * 8 + hn) * 64) * 8192 + widn * 512 + lane_e * 8; const bf16_t* vbn = van + 8 * 512;
#pragma unroll
        for (int tn = 0; tn < 2; ++tn) { const int stn = ((tn + rotn) & 3) * STG;
            __builtin_amdgcn_global_load_lds((const GAS unsigned*)(k1n + (size_t)tn * 4096), (LAS unsigned*)(lds + stn + dk1), 16, 0, 0);
            __builtin_amdgcn_global_load_lds((const GAS unsigned*)(k2n + (size_t)tn * 4096), (LAS unsigned*)(lds + stn + dk2), 16, 0, 0);
            __builtin_amdgcn_global_load_lds((const GAS unsigned*)(van + (size_t)tn * 8192), (LAS unsigned*)(lds + stn + dva), 16, 0, 0);
            __builtin_amdgcn_global_load_lds((const GAS unsigned*)(vbn + (size_t)tn * 8192), (LAS unsigned*)(lds + stn + dvb), 16, 0, 0); }
#pragma unroll
        for (int d0 = 0; d0 < 4; ++d0) qr[d0] = *(const bf16x8*)(P.Q + ((size_t)bn * SEQ + qbn * 128 + 32 * qs + r32e) * D + hn * 128 + map * 64 + d0 * 16 + hie * 8);
        if (tid < 128) btp = P.bt[hn * 128 + tid] - P.bt[hn * 128 + 127];
        if (tid == 0) popv = __hip_atomic_fetch_add(qctr, 1u, __ATOMIC_RELAXED, __HIP_MEMORY_SCOPE_AGENT);
    }
    const int xb = STGOF(NTL - 2);
    LAS float* xq = (LAS float*)(lds + xb) + qs * 4096;
    if (map == 1) {
#pragma unroll
        for (int db = 0; db < 4; ++db)
#pragma unroll
            for (int r = 0; r < 16; ++r) xq[crow(r, hie) * 128 + db * 32 + r32e] = o[db][r];
    }
    WG_BAR();
    if (map == 0) {
        const float lam = P.lam[0];
        float ss[16];
#pragma unroll
        for (int r = 0; r < 16; ++r) { float s = 0.f;
#pragma unroll
            for (int db = 0; db < 4; ++db) { const float v = o[db][r] - lam * xq[crow(r, hie) * 128 + db * 32 + r32e]; o[db][r] = v; s += v * v; }
            ss[r] = s; }
#pragma unroll
        for (int r = 0; r < 16; ++r) { float s = ss[r];
#pragma unroll
            for (int of = 1; of < 32; of <<= 1) s += __shfl_xor(s, of);
            ss[r] = (1.0f - LAM_INIT) / sqrtf(s * (1.0f / 128.0f) + EPS); }
        LAS unsigned char* os = lds + xb + qs * 16384;
#pragma unroll
        for (int db = 0; db < 4; ++db) { const float g = P.subg[db * 32 + r32e];
#pragma unroll
            for (int r = 0; r < 16; ++r) { const unsigned yb = cvtpk(o[db][r] * ss[r] * g, 0.f); *(LAS unsigned short*)(os + crow(r, hie) * OSP + (db * 32 + r32e) * 2) = (unsigned short)(yb & 0xffffu); } }
        LDS_WAIT();
        bf16_t* yg = P.Y + (rowb + qw0) * D + h * 128;
#pragma unroll
        for (int i = 0; i < 8; ++i) { const int cid = i * 64 + lane_e, row = cid >> 4, ch = cid & 15; *(u32x4*)(yg + (size_t)row * D + ch * 8) = *(const LAS u32x4*)(os + row * OSP + ch * 16); }
    }
    WG_BAR();
    item = nxt; rot = rotn; pre = true;
#undef STGOF
}
#undef ATT_PK
}

namespace router {
constexpr int L_LG = 0  , L_HIST = 32768  , L_BASE = 32768 + 128  ;
struct Tensors { const float* x; const bf16_t* delta; const float* g; const bf16_t* rfrag; const float* brouter; bf16_t* hf; unsigned* list; float* rs; float* wt; unsigned* cnt; };
__device__ __forceinline__ void block(LAS unsigned char* lds, const Tensors& P, int tb) {
    const int tid = threadIdx.x, lane = tid & 63, wid = __builtin_amdgcn_readfirstlane(tid >> 6), l16 = lane & 15, q4 = lane >> 4;
    LAS unsigned* hist = (LAS unsigned*)(lds + L_HIST); LAS unsigned* basew = (LAS unsigned*)(lds + L_BASE);
    if (tid < 32) hist[tid] = 0u;
    const int tok = tb * 128 + wid * 16 + l16;
    const float* xrow = P.x + (size_t)tok * D + 8 * q4; const bf16_t* drow = P.delta + (size_t)tok * D + 8 * q4; unsigned char* hrow = (unsigned char*)P.hf + (size_t)tok * D + 8 * q4;
    f32x4 acc0 = {0.f, 0.f, 0.f, 0.f}, acc1 = acc0; float ss = 0.f;
#pragma unroll 4
    for (int ks = 0; ks < 32; ++ks) {
        const f32x4 xa = *(const f32x4*)(xrow + ks * 32), xb = *(const f32x4*)(xrow + ks * 32 + 4);
        const u32x4 dv = *(const u32x4*)(drow + ks * 32);
        const f32x4 ga = *(const f32x4*)(P.g + ks * 32 + 8 * q4), gb = *(const f32x4*)(P.g + ks * 32 + 8 * q4 + 4);
        f32x4 da, db; epi::unpack8(dv, da, db);
        const f32x4 ya = xa + da, yb = xb + db;
        ss += (ya[0] * ya[0] + ya[1] * ya[1]) + (ya[2] * ya[2] + ya[3] * ya[3]) + (yb[0] * yb[0] + yb[1] * yb[1]) + (yb[2] * yb[2] + yb[3] * yb[3]);
        const f32x4 va = ya * ga, vb = yb * gb;
        const u32x4 hw = epi::pack8(va, vb);
        { u32x2 h8; h8.x = cvt4_fp8(va[0], va[1], va[2], va[3]); h8.y = cvt4_fp8(vb[0], vb[1], vb[2], vb[3]); *(u32x2*)(hrow + ks * 32) = h8; }
        f32x4 ha, hb; epi::unpack8(hw, ha, hb);
        const u32x4 lw = epi::pack8(va - ha, vb - hb);
        const bf16x8 bh = __builtin_bit_cast(bf16x8, hw), bl = __builtin_bit_cast(bf16x8, lw);
        const bf16x8* fr = (const bf16x8*)P.rfrag + (size_t)ks * 256 + lane;
        const bf16x8 ah0 = fr[0], al0 = fr[64], ah1 = fr[128], al1 = fr[192];
        acc0 = __builtin_amdgcn_mfma_f32_16x16x32_bf16(ah0, bh, acc0, 0, 0, 0); acc0 = __builtin_amdgcn_mfma_f32_16x16x32_bf16(al0, bh, acc0, 0, 0, 0); acc0 = __builtin_amdgcn_mfma_f32_16x16x32_bf16(ah0, bl, acc0, 0, 0, 0);
        acc1 = __builtin_amdgcn_mfma_f32_16x16x32_bf16(ah1, bh, acc1, 0, 0, 0); acc1 = __builtin_amdgcn_mfma_f32_16x16x32_bf16(al1, bh, acc1, 0, 0, 0); acc1 = __builtin_amdgcn_mfma_f32_16x16x32_bf16(ah1, bl, acc1, 0, 0, 0);
    }
    ss += __shfl_xor(ss, 16); ss += __shfl_xor(ss, 32);
    const float rstd = 1.0f / sqrtf(ss * (1.0f / D) + EPS);
    LAS float* lg = (LAS float*)(lds + L_LG) + (wid * 16 + l16) * 33;
#pragma unroll
    for (int j = 0; j < 4; ++j) { lg[4 * q4 + j] = acc0[j] * rstd + P.brouter[4 * q4 + j]; lg[16 + 4 * q4 + j] = acc1[j] * rstd + P.brouter[16 + 4 * q4 + j]; }
    LB();
    int se[4] = {0, 0, 0, 0}; float sw[4] = {0.f, 0.f, 0.f, 0.f}; unsigned rk[4] = {0u, 0u, 0u, 0u};
    if (q4 == 0) {
        float v[32];
#pragma unroll
        for (int e = 0; e < 32; ++e) v[e] = lg[e];
        float tv[4];
#pragma unroll
        for (int k = 0; k < 4; ++k) { float best = -INFINITY; int bi = 0;
#pragma unroll
            for (int e = 0; e < 32; ++e) { const bool tk = v[e] > best; best = tk ? v[e] : best; bi = tk ? e : bi; }
            tv[k] = best; se[k] = bi;
#pragma unroll
            for (int e = 0; e < 32; ++e) v[e] = (e == bi) ? -INFINITY : v[e]; }
        float den = 0.f;
#pragma unroll
        for (int k = 0; k < 4; ++k) { sw[k] = fast_exp2((tv[k] - tv[0]) * LOG2E); den += sw[k]; }
        const float rd = 1.0f / den;
#pragma unroll
        for (int k = 0; k < 4; ++k) { sw[k] *= rd; rk[k] = __hip_atomic_fetch_add(hist + se[k], 1u, __ATOMIC_RELAXED, __HIP_MEMORY_SCOPE_WORKGROUP); }
    }
    LB();
    if (tid < 32) basew[tid] = __hip_atomic_fetch_add(P.cnt + tid, hist[tid], RLX_AGENT);
    LB();
    if (q4 == 0) {
#pragma unroll
        for (int k = 0; k < 4; ++k) { const size_t pos = (size_t)se[k] * T + basew[se[k]] + rk[k];
            P.list[pos] = (unsigned)tok * 4u + (unsigned)k; P.rs[pos] = rstd; P.wt[pos] = sw[k]; }
    }
    LB();
}
}

__device__ __forceinline__ void final_row(const float* xrow, const bf16_t* drow, const bf16_t* yrows, float* orow, const f32x4 (&g)[4], int lane) {
    f32x4 v[4]; float s = 0.f;
#pragma unroll
    for (int j = 0; j < 4; ++j) { v[j] = *((const f32x4*)xrow + lane + 64 * j);
        const u32x2 dw = *((const u32x2*)drow + lane + 64 * j); v[j] += (f32x4){bflo(dw.x), bfhi(dw.x), bflo(dw.y), bfhi(dw.y)};
#pragma unroll
        for (int k = 0; k < 4; ++k) { const u32x2 yw = *((const u32x2*)(yrows + (size_t)k * D) + lane + 64 * j); v[j] += (f32x4){bflo(yw.x), bfhi(yw.x), bflo(yw.y), bfhi(yw.y)}; }
        s += (v[j].x * v[j].x + v[j].y * v[j].y) + (v[j].z * v[j].z + v[j].w * v[j].w); }
    const float rstd = 1.0f / sqrtf(wave_sum(s) * (1.f / D) + EPS);
#pragma unroll
    for (int j = 0; j < 4; ++j) *((f32x4*)orow + lane + 64 * j) = v[j] * rstd * g[j];
}

constexpr int NPH = 10;
constexpr int N_LAUNCHES = MK_N_LAUNCHES;
__global__ void __launch_bounds__(NTHREADS, 2) hybrid_fwd(Args args) {
    extern __shared__ __attribute__((aligned(16))) unsigned char lds_raw[];
    LAS unsigned char* lds = (LAS unsigned char*)lds_raw;
    LAS unsigned* LW = (LAS unsigned*)(lds + LDSCTL_OFF);
    const int tid = threadIdx.x, lane = tid & 63, wave = __builtin_amdgcn_readfirstlane(tid >> 6);
    const int G = gridDim.x, bx = blockIdx.x;
    unsigned char* ws = args.ws;
    gu32* ctl = (gu32*)(ws + WS_CTL);
    for (int u = tid; u < (LDS_BYTES - LDSCTL_OFF) / 4; u += NTHREADS) LW[u] = 0u;
    __syncthreads();
    XcdBarrier bar; bar.bar = (unsigned*)ctl + CW_BAR; bar.x = 0; bar.st = nullptr;
    if (N_LAUNCHES != NPH) bar = xcd_barrier_post((unsigned*)ctl + CW_BAR + args.li * XCD_BAR_WORDS, (volatile LAS unsigned*)(LW + LW_BAR));
    const int lo = args.ph_lo, hi = args.ph_hi;
#ifndef PH_MASK
#define PH_MASK 0x3ff
#endif
#define IN(k) ((((PH_MASK) >> (k)) & 1) && lo <= (k) && (k) < hi)
#define SEAM(k) do { if (IN(k) && IN((k) + 1)) xcd_barrier(bar); } while (0)
    bf16_t* WinT = (bf16_t*)(ws + WS_WIN_T); bf16_t* WrnnT = (bf16_t*)(ws + WS_WRNN_T); bf16_t* WattT = (bf16_t*)(ws + WS_WATT_T); bf16_t* WoutT = (bf16_t*)(ws + WS_WOUT_T);
    unsigned* LIST = (unsigned*)(ws + WS_LIST); float* RS = (float*)(ws + WS_RS); float* WT = (float*)(ws + WS_WT);
    bf16_t* U1 = (bf16_t*)(ws + WS_U(1)); bf16_t* U2 = (bf16_t*)(ws + WS_U(2)); bf16_t* U3 = (bf16_t*)(ws + WS_U(3)); bf16_t* U4 = (bf16_t*)(ws + WS_U(4));
    bf16_t* U5 = (bf16_t*)(ws + WS_U(5)); bf16_t* U6 = (bf16_t*)(ws + WS_U(6)); bf16_t* U7 = (bf16_t*)(ws + WS_U(7)); bf16_t* U8 = (bf16_t*)(ws + WS_U(8));
    bf16_t* D0 = (bf16_t*)args.out; bf16_t* D1 = D0 + (size_t)T * D;
    unsigned char* misc = ws + WS_MISC;
    bf16_t* RFRAG = (bf16_t*)(misc + MS_RFRAG); float* BT = (float*)(misc + MS_BT); float* SP = (float*)(misc + MS_SP); float* LAM = (float*)(misc + MS_LAM);
    const int gw = bx * NWAVES + wave, NGW = G * NWAVES;

    if (IN(0)) {
        LAS float* scr = (LAS float*)(lds + wave * 16384);
        constexpr int I_IN = (D / 64) * (DIN / 32), I_SQ = (D / 64) * (D / 32);
        unsigned char* Win8 = (unsigned char*)WinT + (size_t)NBF * D * 2;
        for (int it = gw; it < I_IN + 3 * I_SQ; it += NGW) {
            int r = it;
            if (r < I_IN) { if (r % (DIN / 32) < NBF / 32) p0_transpose_item(args.in[I_WIN], D, DIN, WinT, 0, scr, r, lane);
                            else p0_transpose_item_fp8(args.in[I_WIN], D, DIN, Win8, -NBF, scr, r, lane, 32.0f);
                            continue; } r -= I_IN;
            if (r < I_SQ) { p0_transpose_item(args.in[I_WPRNN], D, D, WrnnT, 0, scr, r, lane); continue; } r -= I_SQ;
            if (r < I_SQ) { p0_transpose_item(args.in[I_WPATT], D, D, WattT, 0, scr, r, lane); continue; } r -= I_SQ;
            p0_transpose_item(args.in[I_WOUT], D, D, WoutT, 0, scr, r, lane);
        }
        { f32x4 g[4];
#pragma unroll
          for (int j = 0; j < 4; ++j) g[j] = *((const f32x4*)args.in[I_NMG] + lane + 64 * j);
          for (int m = gw; m < T; m += NGW) rms_row_to_bf16(args.in[I_X] + (size_t)m * D, U1 + (size_t)m * D, (unsigned char*)U8 + (size_t)m * D, g, lane); }
        const int gt = bx * NTHREADS + tid, NGT = G * NTHREADS;
        for (int i = gt; i < 32 * 2 * 64; i += NGT) {
            const int ln = i & 63, half = (i >> 6) & 1, ks = i >> 7; float v[8], l[8]; u32x4 wh, wl;
#pragma unroll
            for (int j = 0; j < 8; ++j) v[j] = args.in[I_WROUTER][(size_t)(ks * 32 + 8 * (ln >> 4) + j) * NEXP + half * 16 + (ln & 15)];
            wh = (u32x4){cvtpk(v[0], v[1]), cvtpk(v[2], v[3]), cvtpk(v[4], v[5]), cvtpk(v[6], v[7])};
            l[0] = v[0] - bflo(wh.x); l[1] = v[1] - bfhi(wh.x); l[2] = v[2] - bflo(wh.y); l[3] = v[3] - bfhi(wh.y); l[4] = v[4] - bflo(wh.z); l[5] = v[5] - bfhi(wh.z); l[6] = v[6] - bflo(wh.w); l[7] = v[7] - bfhi(wh.w);
            wl = (u32x4){cvtpk(l[0], l[1]), cvtpk(l[2], l[3]), cvtpk(l[4], l[5]), cvtpk(l[6], l[7])};
            u32x4* dst = (u32x4*)RFRAG + (size_t)ks * 256 + half * 128 + ln; dst[0] = wh; dst[64] = wl;
        }
        for (int i = gt; i < NH * 128; i += NGT) { const int h = i >> 7, n = i & 127; BT[i] = args.in[I_REL][rel_bucket_dev(n) * NH + h] * LOG2E; }
        for (int i = gt; i < D; i += NGT) SP[i] = log1pf(expf(-args.in[I_LAMBDA][i]));
        if (gt < NH) { float mx = 0.f; for (int bk = 0; bk < 32; ++bk) mx = fmaxf(mx, fabsf(args.in[I_REL][bk * NH + gt] - args.in[I_REL][31 * NH + gt])); ((float*)(misc + MS_BMAX))[gt] = mx * LOG2E; }
        if (gt == 0) { float s1 = 0.f, s2 = 0.f; for (int i = 0; i < 64; ++i) { s1 += args.in[I_DLQ1][i] * args.in[I_DLK1][i]; s2 += args.in[I_DLQ2][i] * args.in[I_DLK2][i]; } LAM[0] = expf(s1) - expf(s2) + LAM_INIT; }
    }
    SEAM(0);
    if (IN(1)) {
        {   pg8::DenseSched S; S.O.init(T, NBF, G, bx); S.A = (const char*)U1; S.Bt = (const char*)WinT;
            epi::EpiProj E; E.out[0] = U2; E.out[1] = U3; E.out[2] = U4; E.out[3] = U5; E.out[4] = U6; E.out[5] = D0; E.out[6] = D1; E.dbg = args.dbg; E.km2 = (unsigned*)ctl + CW_KM2;
            pg8::gemm_phase(lds, S, E); }
        {   pg8::DenseSched8 S; S.O.init(T, DIN - NBF, G, bx); S.A = (const char*)U8; S.Bt = (const char*)WinT + (size_t)NBF * D * 2; S.pn_off = NBF / 256;
            epi::EpiProjT<true> E; E.out[0] = U2; E.out[1] = U3; E.out[2] = U4; E.out[3] = U5; E.out[4] = U6; E.out[5] = D0; E.out[6] = D1; E.dbg = args.dbg; E.km2 = (unsigned*)ctl + CW_KM2;
            pg8::gemm_phase<epi::EpiProjT<true>, pg8::DenseSched8, true>(lds, S, E); }
    }
    SEAM(1);
    if (IN(2)) {
        rglru::Tensors RT{U2, U3, U1, args.in[I_CONVW], args.in[I_CONVB], args.in[I_WRGA], args.in[I_BRGA], args.in[I_WRGX], args.in[I_BRGX], SP};
        att::Tensors AT{U4, U5, U6, U4, BT, args.in[I_SUBG], LAM, (const float*)((const unsigned*)ctl + CW_KM2), (const float*)(misc + MS_BMAX)};
#define POP_ITEM(dst) do { if (tid == 0) LW[LW_Q] = __hip_atomic_fetch_add(ctl + CW_QUEUE, 1u, RLX_AGENT); WG_BAR(); dst = (int)LW[LW_Q]; WG_BAR(); } while (0)
#ifndef PROBE2_MODE
#define PROBE2_MODE 0
#endif
#ifndef PROBE_DBG
#define PROBE_DBG 0
#endif
        const int qlo = (args.li == 1 && PROBE2_MODE == 2) ? 128 : 0, qhi = (args.li == 1 && PROBE2_MODE == 1) ? 128 : 128 + 2048;
        int item; POP_ITEM(item); item += qlo;
#pragma unroll 1
        while (item < 128) { rglru::unit(lds, RT, item >> 4, item & 15); POP_ITEM(item); item += qlo; }
        if (item < qhi) {
            { int n2; POP_ITEM(n2); (void)n2; }
            int rot = 0; bool pre = false; unsigned popv = 0u; float btp = 0.f; bf16x8 qr[4];
#pragma unroll
            for (int d0 = 0; d0 < 4; ++d0) qr[d0] = (bf16x8){0, 0, 0, 0, 0, 0, 0, 0};
#pragma unroll 1
            while (item < qhi) att::unit(lds, AT, item, rot, pre, popv, btp, qr, qlo, qhi, ctl + CW_QUEUE);
        }
#undef POP_ITEM
    }
    SEAM(2);
    if (IN(3)) {
        LAS float* scr = (LAS float*)(lds + wave * 16384);
        constexpr int I_SQ = (D / 64) * (D / 32);
        const bool copy_first = ((bx >> 3) & 1) != 0;
#define WCOPY_ALL() do { _Pragma("unroll 1") for (int it = gw; it < 3 * NEXP * I_SQ; it += NGW) { const int mat = it / (NEXP * I_SQ), r = it % (NEXP * I_SQ), e = r / I_SQ, ii = r % I_SQ; \
            const float* W = args.in[mat == 0 ? I_WGATE : (mat == 1 ? I_WUP : I_WDOWN)] + (size_t)e * D * D; unsigned char* WTp = (unsigned char*)(mat == 0 ? U3 : (mat == 1 ? U5 : U6)); \
            p0_transpose_item_fp8(W, D, D, WTp, e * D, scr, ii, lane, 32.0f); } } while (0)
        if (copy_first) WCOPY_ALL();
        __syncthreads();
        { pg8::DualSched S; S.O.init(T, D, G, bx); S.A0 = (const char*)U1; S.Bt0 = (const char*)WrnnT; S.A1 = (const char*)U4; S.Bt1 = (const char*)WattT;
          epi::EpiMerge E{U8, U2, D0, D1};
          pg8::gemm_phase(lds, S, E); }
        __syncthreads();
        if (!copy_first) WCOPY_ALL();
#undef WCOPY_ALL
    }
    SEAM(3);
    if (IN(4)) { }
    if (IN(5)) {
        pg8::DenseSched S; S.O.init(T, D, G, bx); S.A = (const char*)U2; S.Bt = (const char*)WoutT;
        epi::EpiGate<false, false> E{U7, nullptr, nullptr};
        pg8::gemm_phase(lds, S, E);
    }
    SEAM(5);
    if (IN(6)) {
        router::Tensors RT{args.in[I_X], U7, args.in[I_NFG], RFRAG, args.in[I_BROUTER], U1, LIST, RS, WT, (unsigned*)ctl + CW_CNT};
        for (int tb = bx; tb < T / 128; tb += G) router::block(lds, RT, tb);
    }
    SEAM(6);
    if (IN(7) || IN(8)) {
        { int t2 = tid; asm volatile("" : "+v"(t2));
          if (t2 < 32) LW[LW_CNT + t2] = __hip_atomic_load(ctl + CW_CNT + t2, RLX_AGENT); }
        __syncthreads();
        if (tid == 0) { unsigned acc = 0u; for (int e = 0; e < 32; ++e) { LW[LW_TS + e] = acc; acc += (LW[LW_CNT + e] + 255u) >> 8; } LW[LW_TS + 32] = acc; }
        __syncthreads();
    }
    unsigned char* actb[2] = {(unsigned char*)D0, ws + WS_S};
    if (IN(7)) {
        epi::MoeSched<8, true> S; S.G = G; S.c = bx; S.ntl = __builtin_amdgcn_readfirstlane((int)LW[LW_TS + 32]); S.ts = (const LAS int*)(LW + LW_TS); S.cn = (const LAS int*)(LW + LW_CNT);
        S.A = (const char*)U1; S.list = LIST; S.W0 = (const char*)U3; S.W1 = (const char*)U5;
        S.actbase[0] = actb[0]; S.actbase[1] = actb[1];
        epi::EpiGU E; E.bg = args.in[I_BGATE]; E.bu = args.in[I_BUP]; E.rs = RS; E.actbase[0] = actb[0]; E.actbase[1] = actb[1];
        pg8::gemm_phase<epi::EpiGU, epi::MoeSched<8, true>, true>(lds, S, E);
    }
    SEAM(7);
    if (IN(8)) {
        epi::MoeSched<4, false> S; S.G = G; S.c = bx; S.ntl = __builtin_amdgcn_readfirstlane((int)LW[LW_TS + 32]); S.ts = (const LAS int*)(LW + LW_TS); S.cn = (const LAS int*)(LW + LW_CNT);
        S.A = nullptr; S.list = LIST; S.W0 = (const char*)U6; S.W1 = nullptr;
        S.actbase[0] = actb[0]; S.actbase[1] = actb[1];
        epi::EpiDown E; E.bd = args.in[I_BDOWN]; E.wt = WT; E.list = LIST; E.ybase = (unsigned char*)U1; E.junk = misc + 512 * 1024;
        pg8::gemm_phase<epi::EpiDown, epi::MoeSched<4, false>, true>(lds, S, E);
    }
    SEAM(8);
    if (IN(9)) {
        f32x4 g[4];
#pragma unroll
        for (int j = 0; j < 4; ++j) g[j] = *((const f32x4*)args.in[I_NFINAL] + lane + 64 * j);
        for (int m = gw; m < T; m += NGW) { const bf16_t* yb = U1 + (size_t)m * 4 * D;
            final_row(args.in[I_X] + (size_t)m * D, U7 + (size_t)m * D, yb, args.out + (size_t)m * D, g, lane); }
    }
#undef IN
#undef SEAM
}

extern "C" void kernel_launch(void* const* d_in, const int* in_sizes, int n_in, void* d_out, int out_size, void* d_ws, size_t ws_size, hipStream_t stream) {
    static int grid = 0;
    if (grid == 0) {
        if (n_in != 29 || in_sizes[0] != T * D || out_size != T * D || ws_size < WS_END) { fprintf(stderr, "kernel_launch: unexpected shapes / workspace (n_in %d, ws %zu < %zu)\n", n_in, ws_size, (size_t)WS_END); grid = -1; return; }
        int dev = 0, cus = 0;
        if (hipGetDevice(&dev) != hipSuccess || hipDeviceGetAttribute(&cus, hipDeviceAttributeMultiprocessorCount, dev) != hipSuccess) { grid = -1; return; }
        if (hipFuncSetAttribute((const void*)hybrid_fwd, hipFuncAttributeMaxDynamicSharedMemorySize, LDS_BYTES) != hipSuccess) { fprintf(stderr, "kernel_launch: hipFuncSetAttribute failed\n"); grid = -1; return; }
        int per_cu = 0;
        if (hipOccupancyMaxActiveBlocksPerMultiprocessor(&per_cu, (const void*)hybrid_fwd, NTHREADS, LDS_BYTES) != hipSuccess || per_cu < 1) fprintf(stderr, "kernel_launch: occupancy query reports %d\n", per_cu);
        (void)hipGetLastError();
        grid = cus;
    }
    if (grid < 0) return;
    (void)hipMemsetAsync((char*)d_ws + WS_CTL, 0, CTL_ZERO_BYTES, stream);
    Args a{};
    for (int i = 0; i < 29; ++i) a.in[i] = (const float*)d_in[i];
    a.out = (float*)d_out; a.ws = (unsigned char*)d_ws;
#if defined(PROBE_PHASE)
    { const int k = PROBE_PHASE;
      if (k == 2) {
        a.ph_lo = 0; a.ph_hi = NPH; a.li = 0; hipLaunchKernelGGL(hybrid_fwd, dim3(grid), dim3(NTHREADS), LDS_BYTES, stream, a);
        (void)hipMemsetAsync((char*)d_ws + WS_CTL + CW_QUEUE * 4, 0, 4, stream);
        a.ph_lo = 2; a.ph_hi = 3; a.li = 1; hipLaunchKernelGGL(hybrid_fwd, dim3(grid), dim3(NTHREADS), LDS_BYTES, stream, a);
      } else {
        a.ph_lo = 0; a.ph_hi = k + 1; a.li = 0; hipLaunchKernelGGL(hybrid_fwd, dim3(grid), dim3(NTHREADS), LDS_BYTES, stream, a);
        if (k == 6) (void)hipMemsetAsync((char*)d_ws + WS_CTL + CW_CNT * 4, 0, 32 * 4, stream);
        a.ph_lo = k; a.ph_hi = k + 1; a.li = 1; a.dbg = PROBE_DBG; hipLaunchKernelGGL(hybrid_fwd, dim3(grid), dim3(NTHREADS), LDS_BYTES, stream, a);
        a.dbg = 0;
        if (k + 1 < NPH) { a.ph_lo = k + 1; a.ph_hi = NPH; a.li = 2; hipLaunchKernelGGL(hybrid_fwd, dim3(grid), dim3(NTHREADS), LDS_BYTES, stream, a); }
      } }
#else
    if (N_LAUNCHES == 1) { a.ph_lo = 0; a.ph_hi = NPH; a.li = 0; hipLaunchKernelGGL(hybrid_fwd, dim3(grid), dim3(NTHREADS), LDS_BYTES, stream, a); }
    else for (int p = 0; p < NPH; ++p) { a.ph_lo = p; a.ph_hi = p + 1; a.li = 0; hipLaunchKernelGGL(hybrid_fwd, dim3(grid), dim3(NTHREADS), LDS_BYTES, stream, a); }
#endif
}
```

```cpp
#include <hip/hip_runtime.h>
#include <cstdio>
#include <cstdint>
#include <cmath>

#ifndef MK_N_LAUNCHES
#define MK_N_LAUNCHES 1
#endif

#define GAS __attribute__((address_space(1)))
#define LAS __attribute__((address_space(3)))
typedef unsigned short bf16_t;
typedef short bf16x8 __attribute__((ext_vector_type(8)));
typedef short s16x4 __attribute__((ext_vector_type(4)));
typedef float f32x2 __attribute__((ext_vector_type(2)));
typedef float f32x4 __attribute__((ext_vector_type(4)));
typedef float f32x16 __attribute__((ext_vector_type(16)));
typedef unsigned u32x2 __attribute__((ext_vector_type(2)));
typedef unsigned u32x4 __attribute__((ext_vector_type(4)));
typedef __bf16 bf16x2_t __attribute__((ext_vector_type(2)));
typedef GAS unsigned gu32;

constexpr int BATCH = 8, SEQ = 4096, D = 1024, T = BATCH * SEQ;
constexpr int DIN = 7168, NH = 8, NEXP = 32, TOPK = 4, NPAIR = T * TOPK;
constexpr float EPS = 1e-6f, LOG2E = 1.4426950408889634f;
constexpr float QSCALE = 0.125f * LOG2E;
constexpr float LAM_INIT = 0.2f;

constexpr size_t MiB = 1u << 20;
constexpr size_t WS_CTL = 0, CTL_ZERO_BYTES = 64 * 1024;
constexpr size_t WS_MISC = 1 * MiB;
constexpr size_t WS_WIN_T = 2 * MiB;
constexpr size_t WS_LIST = 2 * MiB, WS_RS = 6 * MiB, WS_WT = 10 * MiB;
constexpr size_t WS_WRNN_T = 16 * MiB, WS_WATT_T = 18 * MiB, WS_WOUT_T = 20 * MiB;
constexpr size_t UNIT = 64 * MiB;
constexpr size_t WS_U(int i) { return 24 * MiB + (size_t)(i - 1) * UNIT; }
constexpr size_t WS_WIN8 = WS_U(8) + 32 * MiB;
constexpr size_t WS_S = 536 * MiB;
constexpr size_t WS_END = 552 * MiB;
constexpr size_t MS_RFRAG = 0;
constexpr size_t MS_BT = 128 * 1024;
constexpr size_t MS_SP = 132 * 1024;
constexpr size_t MS_LAM = 136 * 1024;
constexpr size_t MS_BMAX = 140 * 1024;
#ifndef F8MASK
#define F8MASK 0x73
#endif
constexpr int NF8 = __builtin_popcount(F8MASK & 0x7f);
__host__ __device__ constexpr int f8_rank(int reg) { return __builtin_popcount(F8MASK & ((1 << reg) - 1)); }
__device__ __forceinline__ int nth_region(unsigned mask, int k) { int reg = 0;
#pragma unroll
    for (int r = 0; r < 7; ++r) { const bool on = (mask >> r) & 1u; if (on && k == 0) reg = r; if (on) --k; } return reg; }
constexpr int CW_TMO = 0, CW_CODE = 1, CW_QUEUE = 64, CW_CNT = 128  , CW_KM2 = 256  , CW_BAR = 4096;

constexpr int RING_BYTES = 131072, LDSCTL_OFF = RING_BYTES, LDS_BYTES = 147456;
constexpr int LW_BAR = 0  , LW_Q = 8  , LW_TS = 16  , LW_CNT = 64  , LW_MISC = 128;

#define RLX_AGENT __ATOMIC_RELAXED, __HIP_MEMORY_SCOPE_AGENT
#define LDS_WAIT() asm volatile("s_waitcnt lgkmcnt(0)" ::: "memory")
#define VM_WAIT() asm volatile("s_waitcnt vmcnt(0)" ::: "memory")
#define WG_BAR() asm volatile("s_waitcnt vmcnt(0) lgkmcnt(0)\n\ts_barrier" ::: "memory")
#define SBAR() __builtin_amdgcn_sched_barrier(0)
__device__ __forceinline__ unsigned cvtpk(float lo, float hi) { f32x2 v = {lo, hi}; bf16x2_t b = __builtin_convertvector(v, bf16x2_t); return __builtin_bit_cast(unsigned, b); }
__device__ __forceinline__ unsigned cvt4_fp8(float a, float b, float c, float d) { unsigned w = 0u; w = __builtin_amdgcn_cvt_pk_fp8_f32(a, b, w, false); w = __builtin_amdgcn_cvt_pk_fp8_f32(c, d, w, true); return w; }
__device__ __forceinline__ float bf2f(unsigned short h) { return __uint_as_float((unsigned)h << 16); }
__device__ __forceinline__ float bflo(unsigned w) { return __uint_as_float(w << 16); }
__device__ __forceinline__ float bfhi(unsigned w) { return __uint_as_float(w & 0xffff0000u); }
__device__ __forceinline__ float fast_exp2(float x) { return __builtin_amdgcn_exp2f(x); }
__device__ __forceinline__ float fast_rcp(float x) { return __builtin_amdgcn_rcpf(x); }
__device__ __forceinline__ float sigmoidf_(float x) { return fast_rcp(1.0f + fast_exp2(-x * LOG2E)); }
__device__ __forceinline__ float wave_sum(float v) {
#pragma unroll
    for (int o = 1; o < 64; o <<= 1) v += __shfl_xor(v, o);
    return v;
}

namespace pg8 {
constexpr int BM = 256, BK = 64, HALF = 128, HTB = HALF * BK * 2, STAGE_BYTES = 8 * HTB, KD = 1024;
__host__ __device__ __forceinline__ int lds_byte(int r, int c) { const int st = (r >> 4) * 2 + (c >> 5), rr = r & 15, cc = c & 31, ob = rr * 64 + cc * 2; return st * 1024 + (ob ^ (((ob >> 9) & 1) << 5)); }
__host__ __device__ __forceinline__ void stage_rc(int b, int& R, int& C) { const int st = b / 1024, sb = b % 1024, swz = sb ^ (((sb >> 9) & 1) << 5); R = (st >> 1) * 16 + swz / 64; C = (st & 1) * 32 + (swz % 64) / 2; }
__host__ __device__ __forceinline__ int perm32(int rho) { const int n = rho >> 4, i = rho & 15; return 8 * (i >> 2) + 4 * n + (i & 3); }

__host__ __device__ __forceinline__ size_t btile_off(int n, int kb, int ntb) {
    const int x = n & 31, rho = 16 * ((x >> 2) & 1) + 4 * (x >> 3) + (x & 3), slot = (n & 96) + rho;
    return ((size_t)(n >> 7) * ntb + (kb >> 7)) * 16384 + lds_byte(slot, (kb & 127) >> 1) + (kb & 1);
}
struct UnitG { const char* A; const char* B0; const char* B1; unsigned tk0, tk1; int x0, x1, x2, x3, x4; };

struct TileOrder {
    int nM, nN, nwg, G, c;
    __device__ void init(int M, int N, int G_, int c_) { nM = M / BM; nN = N / BM; nwg = nM * nN; G = G_; c = c_; }
    __device__ bool tile(int i, int& pm, int& pn) const {
        const long L = (long)i * G + c; if (L >= nwg) return false;
        int wgid = (int)L; { const int q = nwg / 8, r = nwg % 8, xcd = wgid % 8, off = wgid / 8; wgid = (xcd < r ? xcd * (q + 1) : r * (q + 1) + (xcd - r) * q) + off; }
        const int nig = 8 * nN, gid = wgid / nig, fm = gid * 8, gsz = (nM - fm) < 8 ? (nM - fm) : 8;
        pm = fm + ((wgid % nig) % gsz); pn = (wgid % nig) / gsz; return true;
    }
};
struct DenseSched {
    TileOrder O; const char* A; const char* Bt; unsigned rmask = 0u;
    __device__ bool next(int i, UnitG& u) const {
        int pm, pn; if (!O.tile(i, pm, pn)) return false; if (rmask) pn = nth_region(rmask, pn >> 2) * 4 + (pn & 3);
        u.A = A + (size_t)pm * (BM * KD * 2); u.B0 = Bt + (size_t)pn * (BM * KD * 2); u.B1 = u.B0 + (size_t)HALF * KD * 2;
        u.tk0 = 0u; u.tk1 = 0u; u.x0 = pm; u.x1 = pn; u.x2 = 0; u.x3 = 0; u.x4 = 0; return true;
    }
    __device__ __forceinline__ void expand(const UnitG&, unsigned& o0, unsigned& o1, unsigned& o2, unsigned& o3) const {
        int R, C; stage_rc((int)threadIdx.x * 16, R, C); o0 = (unsigned)(R * KD + C) * 2u; stage_rc((int)threadIdx.x * 16 + 8192, R, C); o1 = (unsigned)(R * KD + C) * 2u;
        o2 = o0 + (unsigned)(HALF * KD * 2); o3 = o1 + (unsigned)(HALF * KD * 2);
    }
};

struct DenseSched8 {
    TileOrder O; const char* A; const char* Bt; unsigned rmask;
    __device__ bool next(int i, UnitG& u) const {
        int pm, pn; if (!O.tile(i, pm, pn)) return false;
        u.A = A + (size_t)pm * (BM * 1024); u.B0 = Bt + (size_t)pn * (BM * 1024); u.B1 = u.B0 + (size_t)HALF * 1024;
        u.tk0 = 0u; u.tk1 = 0u; u.x0 = pm; u.x1 = nth_region(rmask, pn >> 2) * 4 + (pn & 3); u.x2 = 0; u.x3 = 0; u.x4 = 0; return true;
    }
    __device__ __forceinline__ void expand(const UnitG&, unsigned& o0, unsigned& o1, unsigned& o2, unsigned& o3) const {
        int R, C; stage_rc((int)threadIdx.x * 16, R, C); o0 = (unsigned)(R * 1024 + C * 2); stage_rc((int)threadIdx.x * 16 + 8192, R, C); o1 = (unsigned)(R * 1024 + C * 2);
        o2 = o0 + 128u * 1024u; o3 = o1 + 128u * 1024u;
        asm volatile("" : "+v"(o0), "+v"(o1), "+v"(o2), "+v"(o3));
    }
};

typedef int i32x4 __attribute__((ext_vector_type(4)));
typedef int i32x8 __attribute__((ext_vector_type(8)));
__device__ __forceinline__ i32x8 cat8(const bf16x8 a, const bf16x8 b) { return __builtin_shufflevector(__builtin_bit_cast(i32x4, a), __builtin_bit_cast(i32x4, b), 0, 1, 2, 3, 4, 5, 6, 7); }
struct DualSched {
    TileOrder O; const char* A0; const char* Bt0; const char* A1; const char* Bt1;
    __device__ bool next(int i, UnitG& u) const {
        int pm, pn; if (!O.tile(i >> 1, pm, pn)) return false;
        const int g = i & 1;
        u.A = (g ? A1 : A0) + (size_t)pm * (BM * KD * 2); u.B0 = (g ? Bt1 : Bt0) + (size_t)pn * (BM * KD * 2); u.B1 = u.B0 + (size_t)HALF * KD * 2;
        u.tk0 = 0u; u.tk1 = 0u; u.x0 = pm; u.x1 = pn; u.x2 = g; u.x3 = 0; u.x4 = 0; return true;
    }
    __device__ __forceinline__ void expand(const UnitG&, unsigned& o0, unsigned& o1, unsigned& o2, unsigned& o3) const {
        int R, C; stage_rc((int)threadIdx.x * 16, R, C); o0 = (unsigned)(R * KD + C) * 2u; stage_rc((int)threadIdx.x * 16 + 8192, R, C); o1 = (unsigned)(R * KD + C) * 2u;
        o2 = o0 + (unsigned)(HALF * KD * 2); o3 = o1 + (unsigned)(HALF * KD * 2);
    }
};
template <class Epi, class Sched, bool FP8 = false>
__device__ __forceinline__ void gemm_phase(LAS unsigned char* lds, const Sched& S, const Epi& E) {
    constexpr int PB = FP8 ? 1024 : 2048, NT = FP8 ? 8 : 16;
    const int tid = threadIdx.x, wid = __builtin_amdgcn_readfirstlane(tid >> 6), lane = tid & 63, wr = wid >> 2, wc = wid & 3, fr = lane & 15, fq = lane >> 4;
    static_assert(Epi::PERM, "weights are stored in the PERM tiled layout");
    const unsigned voffB0 = (unsigned)tid * 16u;
    constexpr size_t kstep = (size_t)(BK * 2), kstepB = 16384;
    const unsigned ldsw = (unsigned)wid * 1024u;
    const int aoff = lds_byte(wr * 64 + fr, fq * 8), boff = lds_byte(wc * 32 + fr, fq * 8);
#define PG8_SA(b, h) (((b) * 2 + (h)) * HTB)
#define PG8_SB(b, h) ((4 + (b) * 2 + (h)) * HTB)
#define PG8_STAGEB(bufoff, gbase) do { _Pragma("unroll") for (int _i = 0; _i < 2; ++_i) \
        __builtin_amdgcn_global_load_lds((const GAS unsigned*)((const char*)(gbase) + voffB0 + _i * 8192), (LAS unsigned*)(lds + (bufoff) + ldsw + _i * 8192), 16, 0, 0); } while (0)
#define PG8_STAGEA(bufoff, gbase, oa, ob) do { \
        __builtin_amdgcn_global_load_lds((const GAS unsigned*)((const char*)(gbase) + (oa)), (LAS unsigned*)(lds + (bufoff) + ldsw), 16, 0, 0); \
        __builtin_amdgcn_global_load_lds((const GAS unsigned*)((const char*)(gbase) + (ob)), (LAS unsigned*)(lds + (bufoff) + ldsw + 8192), 16, 0, 0); } while (0)
#define PG8_LDA(dst, b, h) do { _Pragma("unroll") for (int m = 0; m < 4; ++m) { const i32x4 l0_ = *(const LAS i32x4*)(lds + PG8_SA(b, h) + aoff + m * 2048), l1_ = *(const LAS i32x4*)(lds + PG8_SA(b, h) + aoff + m * 2048 + 1024); dst[m] = __builtin_shufflevector(l0_, l1_, 0, 1, 2, 3, 4, 5, 6, 7); } } while (0)
#define PG8_LDB(dst, b, h) do { _Pragma("unroll") for (int n = 0; n < 2; ++n) { const i32x4 l0_ = *(const LAS i32x4*)(lds + PG8_SB(b, h) + boff + n * 2048), l1_ = *(const LAS i32x4*)(lds + PG8_SB(b, h) + boff + n * 2048 + 1024); dst[n] = __builtin_shufflevector(l0_, l1_, 0, 1, 2, 3, 4, 5, 6, 7); } } while (0)
#define PG8_HALF(v, k) __builtin_bit_cast(bf16x8, __builtin_shufflevector(v, v, 4 * (k), 4 * (k) + 1, 4 * (k) + 2, 4 * (k) + 3))
#define PG8_MMA(ai, bj, At, Bt) do { __builtin_amdgcn_s_setprio(1); _Pragma("unroll") for (int m = 0; m < 4; ++m) _Pragma("unroll") for (int n = 0; n < 2; ++n) { \
        if constexpr (FP8) acc[ai][bj][m][n] = __builtin_amdgcn_mfma_scale_f32_16x16x128_f8f6f4(Bt[n], At[m], acc[ai][bj][m][n], 0, 0, 0, 0x7f7f7f7f, 0, 0x7f7f7f7f); \
        else { acc[ai][bj][m][n] = __builtin_amdgcn_mfma_f32_16x16x32_bf16(PG8_HALF(Bt[n], 0), PG8_HALF(At[m], 0), acc[ai][bj][m][n], 0, 0, 0); acc[ai][bj][m][n] = __builtin_amdgcn_mfma_f32_16x16x32_bf16(PG8_HALF(Bt[n], 1), PG8_HALF(At[m], 1), acc[ai][bj][m][n], 0, 0, 0); } } __builtin_amdgcn_s_setprio(0); } while (0)
#define PG8_WAIT_V(n) asm volatile("s_waitcnt vmcnt(" #n ")" ::: "memory")
#define PG8_WAIT_L(n) asm volatile("s_waitcnt lgkmcnt(" #n ")" ::: "memory")
#define PG8_BAR __builtin_amdgcn_s_barrier()
#define PG8_SCHED __builtin_amdgcn_sched_barrier(0)
    UnitG cur, nxt; int ui = 0;
    if (!S.next(0, cur)) return;
    f32x4 acc[2][2][4][2];
#pragma unroll
    for (int a = 0; a < 2; ++a)
#pragma unroll
        for (int b = 0; b < 2; ++b)
#pragma unroll
            for (int m = 0; m < 4; ++m)
#pragma unroll
                for (int n = 0; n < 2; ++n) acc[a][b][m][n] = (f32x4){0.f, 0.f, 0.f, 0.f};
    i32x8 At[4], B0[2], B1[2];
    const char* cA = cur.A; const char* cB0 = cur.B0; const char* cB1 = cur.B1;
    unsigned ca0, ca1, ca2, ca3; S.expand(cur, ca0, ca1, ca2, ca3);
    PG8_STAGEB(PG8_SB(0, 0), cB0); PG8_STAGEB(PG8_SB(0, 1), cB1); PG8_STAGEA(PG8_SA(0, 0), cA, ca0, ca1); PG8_STAGEA(PG8_SA(0, 1), cA, ca2, ca3);
    if (wr == 1) PG8_BAR;
    PG8_WAIT_V(2); PG8_BAR;
    PG8_STAGEB(PG8_SB(1, 0), cB0 + kstepB); PG8_STAGEA(PG8_SA(1, 0), cA + kstep, ca0, ca1); PG8_STAGEB(PG8_SB(1, 1), cB1 + kstepB);
    PG8_WAIT_V(6); PG8_BAR;
    for (;;) {
        const bool has_next = S.next(ui + 1, nxt);
        const char* nA = has_next ? nxt.A : cA; const char* nB0 = has_next ? nxt.B0 : cB0; const char* nB1 = has_next ? nxt.B1 : cB1;
#pragma unroll 1
        for (int t = 0; t < NT; t += 2) {
            const bool last = (t == NT - 2);
            const char* a1 = cA + (size_t)(t + 1) * kstep;
            const char* a2 = last ? nA : cA + (size_t)(t + 2) * kstep;
            const char* b02 = last ? nB0 : cB0 + (size_t)(t + 2) * kstepB; const char* b12 = last ? nB1 : cB1 + (size_t)(t + 2) * kstepB;
            const char* a3 = a2 + kstep; const char* b03 = b02 + kstepB; const char* b13 = b12 + kstepB;
            PG8_LDB(B0, 0, 0); PG8_LDB(B1, 0, 1); PG8_SCHED; PG8_LDA(At, 0, 0); PG8_STAGEA(PG8_SA(1, 1), a1, ca2, ca3);
            if (last && has_next) S.expand(nxt, ca0, ca1, ca2, ca3);
            if constexpr (Epi::NSTORES == 16) { if (t == 0 && ui > 0) PG8_WAIT_V(24); else PG8_WAIT_V(8); } else PG8_WAIT_V(8);
            PG8_WAIT_L(0); PG8_BAR; PG8_MMA(0, 0, At, B0); PG8_MMA(0, 1, At, B1); PG8_BAR; PG8_SCHED;
            PG8_LDA(At, 0, 1); PG8_STAGEB(PG8_SB(0, 0), b02); PG8_STAGEB(PG8_SB(0, 1), b12); PG8_STAGEA(PG8_SA(0, 0), a2, ca0, ca1);
            if constexpr (Epi::NSTORES == 16) { if (t == 0 && ui > 0) PG8_WAIT_V(24); else PG8_WAIT_V(8); } else PG8_WAIT_V(8);
            PG8_WAIT_L(0); PG8_BAR; PG8_MMA(1, 0, At, B0); PG8_MMA(1, 1, At, B1); PG8_BAR; PG8_SCHED;
            PG8_LDB(B0, 1, 0); PG8_LDB(B1, 1, 1); PG8_SCHED; PG8_LDA(At, 1, 0); PG8_STAGEA(PG8_SA(0, 1), a2, ca2, ca3);
            PG8_WAIT_V(8); PG8_WAIT_L(0); PG8_BAR; PG8_MMA(0, 0, At, B0); PG8_MMA(0, 1, At, B1); PG8_BAR; PG8_SCHED;
            PG8_LDA(At, 1, 1); PG8_STAGEB(PG8_SB(1, 0), b03); PG8_STAGEB(PG8_SB(1, 1), b13); PG8_STAGEA(PG8_SA(1, 0), a3, ca0, ca1);
            PG8_WAIT_V(8); PG8_WAIT_L(0); PG8_BAR; PG8_MMA(1, 0, At, B0); PG8_MMA(1, 1, At, B1); PG8_BAR; PG8_SCHED;
        }
        if (wr == 0) PG8_BAR;
        E(acc, cur, wr, wc, fr, fq);
        if (!has_next) break;
#pragma unroll
        for (int a = 0; a < 2; ++a)
#pragma unroll
            for (int b = 0; b < 2; ++b)
#pragma unroll
                for (int m = 0; m < 4; ++m)
#pragma unroll
                    for (int n = 0; n < 2; ++n) acc[a][b][m][n] = (f32x4){0.f, 0.f, 0.f, 0.f};
        cur = nxt; cA = nA; cB0 = nB0; cB1 = nB1;
        ++ui;
        if (wr == 1) PG8_BAR;
    }
    PG8_WAIT_V(0);
    PG8_BAR;
#undef PG8_SA
#undef PG8_SB
#undef PG8_STAGEA
#undef PG8_STAGEB
#undef PG8_LDA
#undef PG8_LDB
#undef PG8_MMA
#undef PG8_WAIT_V
#undef PG8_WAIT_L
#undef PG8_BAR
#undef PG8_SCHED
}
}

namespace epi {
using pg8::UnitG;
__device__ __forceinline__ u32x4 pack8(const f32x4 v0, const f32x4 v1) { u32x4 w; w.x = cvtpk(v0[0], v0[1]); w.y = cvtpk(v0[2], v0[3]); w.z = cvtpk(v1[0], v1[1]); w.w = cvtpk(v1[2], v1[3]); return w; }
__device__ __forceinline__ void unpack8(const u32x4 w, f32x4& v0, f32x4& v1) { v0 = (f32x4){bflo(w.x), bfhi(w.x), bflo(w.y), bfhi(w.y)}; v1 = (f32x4){bflo(w.z), bfhi(w.z), bflo(w.w), bfhi(w.w)}; }

template <bool F8> struct EpiProjT {
    static constexpr bool PERM = true; static constexpr int NSTORES = 0;
    bf16_t* out[7]; int dbg; unsigned* km2;
    __device__ __forceinline__ void operator()(const f32x4 (&acc)[2][2][4][2], const UnitG& u, int wr, int wc, int fr, int fq) const {
        const int reg = u.x1 >> 2;
#define EP_CASE(R) if constexpr ((((F8MASK >> R) & 1) != 0) == F8) { if (reg == R) { body<R>(acc, u, wr, wc, fr, fq); return; } }
        EP_CASE(0) EP_CASE(1) EP_CASE(2) EP_CASE(3) EP_CASE(4) EP_CASE(5) EP_CASE(6)
#undef EP_CASE
    }
    template <int reg> __device__ __forceinline__ void body(const f32x4 (&acc)[2][2][4][2], const UnitG& u, int wr, int wc, int fr, int fq) const {
        asm volatile("" : "+v"(fr), "+v"(fq));
        bf16_t* base = out[reg];
        const int row0 = u.x0 * 256 + wr * 64 + fr, col0 = (u.x1 & 3) * 256 + wc * 32 + 8 * fq;
        float kss[2] = {0.f, 0.f};
#pragma unroll
        for (int ai = 0; ai < 2; ++ai)
#pragma unroll
            for (int m = 0; m < 4; ++m) { const int row = row0 + ai * 128 + m * 16; bf16_t* rowp = base + (size_t)row * D + col0;
                const int bq = row >> 12, sq = row & 4095, tile = sq >> 6, key = sq & 63;
#pragma unroll
                for (int bj = 0; bj < 2; ++bj) { f32x4 v0 = acc[ai][bj][m][0], v1 = acc[ai][bj][m][1];
                    if (F8) { v0 = v0 * (1.0f / 32.0f); v1 = v1 * (1.0f / 32.0f); }
                    if (reg >= 5) {
#pragma unroll
                        for (int j = 0; j < 4; ++j) { v0[j] = sigmoidf_(v0[j]); v1[j] = sigmoidf_(v1[j]); } }
                    else if (reg == 2) { v0 = v0 * QSCALE; v1 = v1 * QSCALE; }
                    u32x4* dst = (u32x4*)(rowp + bj * 128);
                    if (reg == 3 || reg == 4) { const int col = col0 + bj * 128, hh = col >> 7;
                        const size_t off16 = (reg == 3) ? ((((size_t)((bq * 8 + hh) * 2 + ((col >> 6) & 1)) * 64 + tile) * 8 + ((col >> 3) & 7)) * 64 + key)
                                                        : ((((size_t)(bq * 8 + hh) * 64 + tile) * 16 + ((col >> 5) & 3) * 4 + (key >> 4)) * 64 + (key & 15) * 4 + ((col >> 3) & 3));
                        dst = (u32x4*)base + off16; }
                    __builtin_nontemporal_store(pack8(v0, v1), dst);
                    if (reg == 3) { kss[bj] = fmaxf(kss[bj], (v0[0] * v0[0] + v0[1] * v0[1]) + (v0[2] * v0[2] + v0[3] * v0[3]) + (v1[0] * v1[0] + v1[1] * v1[1]) + (v1[2] * v1[2] + v1[3] * v1[3])); } } }
        if (reg == 3) {
#pragma unroll
            for (int bj = 0; bj < 2; ++bj) { float s = kss[bj];
                s += __shfl_xor(s, 16); s += __shfl_xor(s, 32);
#pragma unroll
                for (int of = 1; of < 16; of <<= 1) s = fmaxf(s, __shfl_xor(s, of));
                if ((fr | fq) == 0) __hip_atomic_fetch_max(km2 + (((u.x0 >> 4) * 8 + (u.x1 & 3) * 2 + bj) * 2 + (wc >> 1)) * 2 + (wc & 1), __float_as_uint(s), RLX_AGENT); } }
    }
};
using EpiProj = EpiProjT<false>;
template <bool GATE, bool ADD> struct EpiGate {
    static constexpr bool PERM = true; static constexpr int NSTORES = 0;
    bf16_t* out; const bf16_t* gate; const bf16_t* addsrc;
    __device__ __forceinline__ void operator()(const f32x4 (&acc)[2][2][4][2], const UnitG& u, int wr, int wc, int fr, int fq) const {
        asm volatile("" : "+v"(fr), "+v"(fq));
        const int row0 = u.x0 * 256 + wr * 64 + fr, col0 = u.x1 * 256 + wc * 32 + 8 * fq;
#pragma unroll
        for (int ai = 0; ai < 2; ++ai)
#pragma unroll
            for (int m = 0; m < 4; ++m) { const size_t off = (size_t)(row0 + ai * 128 + m * 16) * D + col0;
#pragma unroll
                for (int bj = 0; bj < 2; ++bj) { f32x4 v0 = acc[ai][bj][m][0], v1 = acc[ai][bj][m][1];
                    if (GATE) { f32x4 g0, g1; unpack8(*(const u32x4*)(gate + off + bj * 128), g0, g1); v0 = v0 * g0; v1 = v1 * g1; }
                    if (ADD) { f32x4 a0, a1; unpack8(*(const u32x4*)(addsrc + off + bj * 128), a0, a1); v0 = v0 + a0; v1 = v1 + a1; }
                    *(u32x4*)(out + off + bj * 128) = pack8(v0, v1); } }
    }
};
struct EpiMerge {
    static constexpr bool PERM = true; static constexpr int NSTORES = 0;
    bf16_t* m1; bf16_t* out; const bf16_t* g0; const bf16_t* g1;
    __device__ __forceinline__ void operator()(const f32x4 (&acc)[2][2][4][2], const UnitG& u, int wr, int wc, int fr, int fq) const {
        asm volatile("" : "+v"(fr), "+v"(fq));
        const int row0 = u.x0 * 256 + wr * 64 + fr, col0 = u.x1 * 256 + wc * 32 + 8 * fq; const bool second = u.x2 != 0;
        const bf16_t* gate = second ? g1 : g0; bf16_t* dst = second ? out : m1;
#pragma unroll
        for (int ai = 0; ai < 2; ++ai) {
            u32x4 gv[4][2], mv[4][2];
#pragma unroll
            for (int m = 0; m < 4; ++m) { const size_t off = (size_t)(row0 + ai * 128 + m * 16) * D + col0;
#pragma unroll
                for (int bj = 0; bj < 2; ++bj) gv[m][bj] = *(const u32x4*)(gate + off + bj * 128); }
            if (second) {
#pragma unroll
                for (int m = 0; m < 4; ++m) { const size_t off = (size_t)(row0 + ai * 128 + m * 16) * D + col0;
#pragma unroll
                    for (int bj = 0; bj < 2; ++bj) mv[m][bj] = *(const u32x4*)(m1 + off + bj * 128); } }
            else {
#pragma unroll
                for (int m = 0; m < 4; ++m) { mv[m][0] = (u32x4){0u, 0u, 0u, 0u}; mv[m][1] = mv[m][0]; } }
#pragma unroll
            for (int m = 0; m < 4; ++m) { const size_t off = (size_t)(row0 + ai * 128 + m * 16) * D + col0;
#pragma unroll
                for (int bj = 0; bj < 2; ++bj) { f32x4 v0 = acc[ai][bj][m][0], v1 = acc[ai][bj][m][1];
                    f32x4 ga, gb; unpack8(gv[m][bj], ga, gb); v0 = v0 * ga; v1 = v1 * gb;
                    f32x4 a0, a1; unpack8(mv[m][bj], a0, a1); v0 = v0 + a0; v1 = v1 + a1;
                    *(u32x4*)(dst + off + bj * 128) = pack8(v0, v1); } } }
    }
};
struct EpiGU {
    static constexpr bool PERM = true; static constexpr int NSTORES = 0;
    const float* bg; const float* bu; const float* rs; unsigned char* actbase[2];
    __device__ __forceinline__ void operator()(const f32x4 (&acc)[2][2][4][2], const UnitG& u, int wr, int wc, int fr, int fq) const {
        asm volatile("" : "+v"(fr), "+v"(fq));
        const int tile = u.x0, e = u.x2, rl0 = u.x3, nval = u.x4;
        const int ff0 = u.x1 * 128 + wc * 32 + 8 * fq;
        const f32x4 bg0 = *(const f32x4*)(bg + e * D + ff0), bg1 = *(const f32x4*)(bg + e * D + ff0 + 4), bu0 = *(const f32x4*)(bu + e * D + ff0), bu1 = *(const f32x4*)(bu + e * D + ff0 + 4);
        unsigned char* abase = ((tile >> 9) == 0 ? actbase[0] : actbase[1]) + (size_t)(tile & 511) * (256 * D);
        const float* rsp = rs + (size_t)e * T + rl0;
        float rsv[8];
#pragma unroll
        for (int i = 0; i < 8; ++i) { const int r = (i >> 2) * 128 + wr * 64 + (i & 3) * 16 + fr; const float v_ = rsp[min(r, nval - 1)];
            rsv[i] = (r < nval) ? v_ * (1.0f / 32.0f) : 0.f; }
#pragma unroll
        for (int ai = 0; ai < 2; ++ai)
#pragma unroll
            for (int m = 0; m < 4; ++m) { const int r = ai * 128 + wr * 64 + m * 16 + fr;
                const float rstd = rsv[ai * 4 + m];
                f32x4 g0 = acc[ai][0][m][0] * rstd + bg0, g1 = acc[ai][0][m][1] * rstd + bg1, u0 = acc[ai][1][m][0] * rstd + bu0, u1 = acc[ai][1][m][1] * rstd + bu1;
#pragma unroll
                for (int j = 0; j < 4; ++j) {
                    { const float gm = fminf(g0[j], 7.0f), uc = fminf(fmaxf(u0[j], -7.0f), 7.0f); g0[j] = (4.0f * uc + 4.0f) * (gm * fast_rcp(1.0f + fast_exp2(gm * (-1.702f * LOG2E)))); }
                    { const float gm = fminf(g1[j], 7.0f), uc = fminf(fmaxf(u1[j], -7.0f), 7.0f); g1[j] = (4.0f * uc + 4.0f) * (gm * fast_rcp(1.0f + fast_exp2(gm * (-1.702f * LOG2E)))); } }
                u32x2 w; w.x = cvt4_fp8(g0[0], g0[1], g0[2], g0[3]); w.y = cvt4_fp8(g1[0], g1[1], g1[2], g1[3]);
                *(u32x2*)(abase + (size_t)r * D + ff0) = w; }
    }
};
struct EpiDown {
    static constexpr bool PERM = true; static constexpr int NSTORES = 16;
    const float* bd; const float* wt; const unsigned* list; unsigned char* ybase; unsigned char* junk;
    __device__ __forceinline__ void operator()(const f32x4 (&acc)[2][2][4][2], const UnitG& u, int wr, int wc, int fr, int fq) const {
        asm volatile("" : "+v"(fr), "+v"(fq));
        const int e = u.x2, rl0 = u.x3, nval = u.x4;
        const int c0 = u.x1 * 256 + wc * 32 + 8 * fq;
        f32x4 bv[2][2];
#pragma unroll
        for (int bj = 0; bj < 2; ++bj) { bv[bj][0] = *(const f32x4*)(bd + e * D + c0 + bj * 128); bv[bj][1] = *(const f32x4*)(bd + e * D + c0 + bj * 128 + 4); }
        const float* wtp = wt + (size_t)e * T + rl0; const unsigned* lp = list + (size_t)e * T + rl0;
        unsigned pr[8]; float wv[8];
#pragma unroll
        for (int i = 0; i < 8; ++i) { const int r = (i >> 2) * 128 + wr * 64 + (i & 3) * 16 + fr, rc = min(r, nval - 1); const bool ok = r < nval; const unsigned p_ = lp[rc]; const float w_ = wtp[rc]; pr[i] = ok ? p_ : 0xffffffffu; wv[i] = ok ? w_ : 0.f; }
#pragma unroll
        for (int ai = 0; ai < 2; ++ai)
#pragma unroll
            for (int m = 0; m < 4; ++m) { const unsigned pair = pr[ai * 4 + m]; const float w = wv[ai * 4 + m];
                {   const bool ok = pair != 0xffffffffu;
                    const unsigned yo = (ok ? pair * 2048u : 0u) + (unsigned)c0 * 2u;
                    unsigned char* yb_ = ok ? ybase : junk;
#pragma unroll
                    for (int bj = 0; bj < 2; ++bj) { const f32x4 v0 = (acc[ai][bj][m][0] * (1.0f / 128.0f) + bv[bj][0]) * w, v1 = (acc[ai][bj][m][1] * (1.0f / 128.0f) + bv[bj][1]) * w; __builtin_nontemporal_store(pack8(v0, v1), (u32x4*)(yb_ + yo + bj * 256)); } } }
    }
};
template <int NPN, bool GATHER> struct MoeSched {
    int G, c, ntl; const LAS int* ts; const LAS int* cn;
    const char* A; const unsigned* list; const char* W0; const char* W1; unsigned char* actbase[2];
    __device__ bool next(int i, UnitG& u) const {
        const int uu = i * G + c, xq = uu & 7, rk = uu >> 3, tile = xq + 8 * (rk / NPN), pn = rk % NPN;
        if (tile >= ntl) return false;
        int e = 0;
#pragma unroll
        for (int st = 16; st >= 1; st >>= 1) { if (ts[e + st] <= tile) e += st; }
        e = __builtin_amdgcn_readfirstlane(e);
        const int rl0 = __builtin_amdgcn_readfirstlane((tile - ts[e]) * 256), nval = __builtin_amdgcn_readfirstlane(cn[e]) - rl0;
        u.x0 = tile; u.x1 = pn; u.x2 = e; u.x3 = rl0; u.x4 = nval;
        if (GATHER) {
            u.A = A; u.B0 = W0 + ((size_t)e * 1024 + pn * 128) * 1024; u.B1 = W1 + ((size_t)e * 1024 + pn * 128) * 1024;
            int R, C; pg8::stage_rc((int)threadIdx.x * 16, R, C);
            unsigned tk[4];
#pragma unroll
            for (int j = 0; j < 4; ++j) { const int r = (j >> 1) * 128 + (j & 1) * 64 + R; tk[j] = list[(size_t)e * T + rl0 + min(r, nval - 1)] >> 2; }
            u.tk0 = tk[0] | (tk[1] << 16); u.tk1 = tk[2] | (tk[3] << 16);
        } else {
            u.A = (const char*)(((tile >> 9) == 0 ? actbase[0] : actbase[1]) + (size_t)(tile & 511) * (256 * D)); u.B0 = W0 + ((size_t)e * 1024 + pn * 256) * 1024; u.B1 = u.B0 + (size_t)128 * 1024;
            u.tk0 = 0u; u.tk1 = 0u;
        }
        return true;
    }
    __device__ __forceinline__ void expand(const UnitG& u, unsigned& o0, unsigned& o1, unsigned& o2, unsigned& o3) const {
        int R, C0, C1; pg8::stage_rc((int)threadIdx.x * 16, R, C0); pg8::stage_rc((int)threadIdx.x * 16 + 8192, R, C1);
        if (GATHER) { o0 = (u.tk0 & 0xffffu) * 1024u + (unsigned)C0 * 2u; o1 = (u.tk0 >> 16) * 1024u + (unsigned)C1 * 2u; o2 = (u.tk1 & 0xffffu) * 1024u + (unsigned)C0 * 2u; o3 = (u.tk1 >> 16) * 1024u + (unsigned)C1 * 2u; }
        else { pg8::stage_rc((int)threadIdx.x * 16, R, C0); o0 = (unsigned)(R * 1024 + C0 * 2); o1 = (unsigned)((R + 64) * 1024 + C1 * 2); o2 = o0 + 128u * 1024u; o3 = o1 + 128u * 1024u;
               asm volatile("" : "+v"(o0), "+v"(o1), "+v"(o2), "+v"(o3)); }
    }
};
}

#define XB_TMO      128
#define XB_XCNT(j)  (256  + 64 * (j))
#define XB_XSUB(j)  (1280 + 64 * (j))
#define XB_XGEN(j)  (2304 + 64 * (j))
#define XB_TOP      3328
#define XB_TOPGEN   3392
#define XCD_BAR_WORDS 3456
#define XB_SPIN_CAP (1u << 18)
__device__ __forceinline__ unsigned xb_ld(unsigned* p)              { return __hip_atomic_load(p, __ATOMIC_RELAXED, __HIP_MEMORY_SCOPE_AGENT); }
__device__ __forceinline__ unsigned xb_add(unsigned* p, unsigned v) { return __hip_atomic_fetch_add(p, v, __ATOMIC_RELAXED, __HIP_MEMORY_SCOPE_AGENT); }
__device__ __forceinline__ unsigned xb_xcc_id() { return (unsigned)__builtin_amdgcn_s_getreg((3 << 11) | 20) & 0xFu; }
#define XB_SPIN(cond, bar) do { unsigned _sp = 0; while (cond) { __builtin_amdgcn_s_sleep(1); \
    if ((++_sp & 255u) == 0u) { if (xb_ld(&(bar)[XB_TMO])) break; if (_sp > XB_SPIN_CAP) { atomicAdd(&(bar)[XB_TMO], 1u); break; } } } } while (0)
struct XcdBarrier { unsigned* bar; unsigned x; volatile LAS unsigned* st; };
__device__ __forceinline__ XcdBarrier xcd_barrier_post(unsigned* bar, volatile LAS unsigned* st) {
    XcdBarrier b; b.bar = bar; b.x = xb_xcc_id(); b.st = st;
    if (threadIdx.x == 0) (void)xb_add(&bar[XB_XCNT(b.x)], 1u);
    return b;
}
__device__ __forceinline__ void xcd_barrier_complete(unsigned* bar, unsigned x, unsigned& nloc, unsigned& nx) {
    const unsigned G = gridDim.x * gridDim.y * gridDim.z;
    unsigned sum, cnt, mine, sp = 0u;
    for (;;) {
        sum = 0u; cnt = 0u; mine = 0u;
#pragma unroll
        for (unsigned j = 0; j < 16; ++j) { const unsigned c = xb_ld(&bar[XB_XCNT(j)]); sum += c; cnt += (c > 0u) ? 1u : 0u; mine = (j == x) ? c : mine; }
        if (sum == G) break;
        __builtin_amdgcn_s_sleep(1);
        if ((++sp & 255u) == 0u) { if (xb_ld(&bar[XB_TMO])) break; if (sp > XB_SPIN_CAP) { atomicAdd(&bar[XB_TMO], 1u); break; } }
    }
    nloc = mine > 0u ? mine : 1u; nx = cnt > 0u ? cnt : 1u;
}
__device__ __forceinline__ void xcd_barrier(const XcdBarrier& b) {
    asm volatile("s_waitcnt vmcnt(0)" ::: "memory");
    __syncthreads();
    if (threadIdx.x == 0) {
        unsigned* bar = b.bar;
        __builtin_amdgcn_s_waitcnt(0);
        unsigned nloc = b.st[0], nx = b.st[1];
        if (nloc == 0u) { xcd_barrier_complete(bar, b.x, nloc, nx); b.st[0] = nloc; b.st[1] = nx; }
        const unsigned old = xb_add(&bar[XB_XSUB(b.x)], 1u);
        const unsigned gen = old / nloc;
        if (old + 1u == (gen + 1u) * nloc) {
            __builtin_amdgcn_fence(__ATOMIC_RELEASE, "agent");
            asm volatile("s_waitcnt vmcnt(0)" ::: "memory");
            const unsigned og = xb_add(&bar[XB_TOP], 1u);
            const unsigned tg = og / nx;
            if (og + 1u == (tg + 1u) * nx) xb_add(&bar[XB_TOPGEN], 1u);
            else XB_SPIN(xb_ld(&bar[XB_TOPGEN]) == tg, bar);
            __builtin_amdgcn_fence(__ATOMIC_ACQUIRE, "agent");
            xb_add(&bar[XB_XGEN(b.x)], 1u);
            asm volatile("s_waitcnt vmcnt(0)" ::: "memory");
        } else {
            XB_SPIN(xb_ld(&bar[XB_XGEN(b.x)]) == gen, bar);
            __builtin_amdgcn_fence(__ATOMIC_ACQUIRE, "agent");
            asm volatile("s_waitcnt vmcnt(0)" ::: "memory");
        }
    }
    __syncthreads();
}

constexpr int NWAVES = 8, NTHREADS = 512;
struct Args { const float* in[29]; float* out; unsigned char* ws; int ph_lo, ph_hi, li, dbg; };
enum { I_X = 0, I_NMG, I_WIN, I_CONVW, I_CONVB, I_WRGA, I_BRGA, I_WRGX, I_BRGX, I_LAMBDA, I_DLQ1, I_DLK1, I_DLQ2, I_DLK2, I_SUBG, I_REL, I_WPRNN, I_WPATT, I_WOUT, I_NFG, I_WROUTER, I_BROUTER,
       I_WGATE, I_BGATE, I_WUP, I_BUP, I_WDOWN, I_BDOWN, I_NFINAL };

__device__ __forceinline__ void p0_transpose_item(const float* W, int K, int N, bf16_t* WT, int row_off, LAS float* scr, int item, int lane) {
    const int nblk = N / 32, kb = item / nblk, nb = item % nblk, k0 = 64 * kb, n0 = 32 * nb;
#pragma unroll 8
    for (int i = 0; i < 32; ++i) { const int kk = 2 * i + (lane >> 5); scr[kk * 33 + (lane & 31)] = W[(size_t)(k0 + kk) * N + n0 + (lane & 31)]; }
    LDS_WAIT(); asm volatile("" ::: "memory");
    const int c = lane & 7;
#pragma unroll
    for (int j = 0; j < 4; ++j) { const int n = (lane >> 3) + 8 * j; const LAS float* s = scr + (8 * c) * 33 + n;
        u32x4 o; o.x = cvtpk(s[0 * 33], s[1 * 33]); o.y = cvtpk(s[2 * 33], s[3 * 33]); o.z = cvtpk(s[4 * 33], s[5 * 33]); o.w = cvtpk(s[6 * 33], s[7 * 33]);
        *(u32x4*)((char*)WT + pg8::btile_off(row_off + n0 + n, (k0 + 8 * c) * 2, K / 64)) = o; }
    LDS_WAIT(); asm volatile("" ::: "memory");
}
__device__ __forceinline__ void p0_transpose_item_fp8(const float* W, int K, int N, unsigned char* WT, int row_off, LAS float* scr, int item, int lane, float scale) {
    const int nblk = N / 32, kb = item / nblk, nb = item % nblk, k0 = 64 * kb, n0 = 32 * nb;
    float wv_[32];
#pragma unroll
    for (int i = 0; i < 32; ++i) { const int kk = 2 * i + (lane >> 5); wv_[i] = W[(size_t)(k0 + kk) * N + n0 + (lane & 31)]; }
#pragma unroll
    for (int i = 0; i < 32; ++i) { const int kk = 2 * i + (lane >> 5); scr[kk * 33 + (lane & 31)] = wv_[i] * scale; }
    LDS_WAIT(); asm volatile("" ::: "memory");
    const int c = lane & 7;
#pragma unroll
    for (int j = 0; j < 4; ++j) { const int n = (lane >> 3) + 8 * j; const LAS float* s = scr + (8 * c) * 33 + n;
        u32x2 o; o.x = cvt4_fp8(s[0 * 33], s[1 * 33], s[2 * 33], s[3 * 33]); o.y = cvt4_fp8(s[4 * 33], s[5 * 33], s[6 * 33], s[7 * 33]);
        *(u32x2*)(WT + pg8::btile_off(row_off + n0 + n, k0 + 8 * c, K / 128)) = o; }
    LDS_WAIT(); asm volatile("" ::: "memory");
}
__device__ __forceinline__ void rms_row_to_bf16(const float* xrow, bf16_t* orow, unsigned char* orow8, const f32x4 (&g)[4], int lane) {
    const f32x4* xr = (const f32x4*)xrow + lane;
    f32x4 v[4]; float s = 0.f;
#pragma unroll
    for (int j = 0; j < 4; ++j) { v[j] = xr[64 * j]; s += (v[j].x * v[j].x + v[j].y * v[j].y) + (v[j].z * v[j].z + v[j].w * v[j].w); }
    const float rstd = 1.0f / sqrtf(wave_sum(s) * (1.f / D) + EPS);
    u32x2* o8 = (u32x2*)orow + lane;
#pragma unroll
    for (int j = 0; j < 4; ++j) { const f32x4 y = v[j] * rstd * g[j]; u32x2 w; w.x = cvtpk(y.x, y.y); w.y = cvtpk(y.z, y.w); o8[64 * j] = w;
        ((unsigned*)orow8 + lane)[64 * j] = cvt4_fp8(y.x, y.y, y.z, y.w); }
}
__device__ __forceinline__ int rel_bucket_dev(int n) {
    if (n < 16) return n;
    const float v = logf((float)n / 16.0f) / logf(8.0f) * 16.0f; int b = 16 + (int)v; return b < 31 ? b : 31;
}

#define LB() asm volatile("s_waitcnt lgkmcnt(0)\n\ts_barrier" ::: "memory")
namespace rglru {
constexpr int TL = 128, PITCH = 144;
constexpr int WV = 9728;
constexpr int W_XR = 0, W_GR = 2816, W_XC = 5120;
constexpr int L_AGG = 8 * WV  , L_CW = L_AGG + 8192  , L_WF = L_CW + 1536  ;
struct Tensors { const bf16_t* xr; const bf16_t* gr; bf16_t* y; const float* conv_w; const float* conv_b; const float* w_a; const float* b_a; const float* w_x; const float* b_x; const float* sp; };

__device__ __forceinline__ void unit(LAS unsigned char* lds, const Tensors& P, int b, int n) {
    const int tid = threadIdx.x, lane = tid & 63, wid = __builtin_amdgcn_readfirstlane(tid >> 6), l16 = lane & 15, q4 = lane >> 4;
    LAS unsigned char* wl = lds + wid * WV;
    LB();
    if (tid < 320) { const int j = tid >> 6, c = tid & 63; ((LAS float*)(lds + L_CW))[tid] = (j < 4) ? P.conv_w[j * D + n * 64 + c] : P.conv_b[n * 64 + c]; }
#pragma unroll 1
    for (int f = wid; f < 16; f += 8) { const int g = f >> 3, db = (f >> 1) & 3, ks = f & 1; const float* W = (g == 0 ? P.w_a : P.w_x) + (size_t)n * 64 * 64; float v[8];
#pragma unroll
        for (int j = 0; j < 8; ++j) v[j] = W[(32 * ks + 8 * q4 + j) * 64 + 16 * db + l16];
        u32x4 w; w.x = cvtpk(v[0], v[1]); w.y = cvtpk(v[2], v[3]); w.z = cvtpk(v[4], v[5]); w.w = cvtpk(v[6], v[7]); *(LAS u32x4*)(lds + L_WF + (f * 64 + lane) * 16) = w; }
    const int sh16 = ((lane - 16) & 63) * 4, sh32 = ((lane - 32) & 63) * 4;
#define RG_UP(v, sh) __int_as_float(__builtin_amdgcn_ds_bpermute(sh, __float_as_int(v)))
    float ba[4], bx[4], sp[4], hin[4];
#pragma unroll
    for (int db = 0; db < 4; ++db) { const int d = n * 64 + 16 * db + l16; ba[db] = P.b_a[d]; bx[db] = P.b_x[d]; sp[db] = P.sp[d] * (-8.0f * LOG2E); hin[db] = 0.f; }
    const size_t rowb = (size_t)b * SEQ;
    const bf16_t* xg = P.xr + n * 64; const bf16_t* gg = P.gr + n * 64; bf16_t* yg = P.y + n * 64;
    u32x4 pxr[3], pgr[2];
    const u32x4 z4 = {0u, 0u, 0u, 0u};
#define RG_LOAD(t0) do { const int tb_ = (t0) + 16 * wid; \
        _Pragma("unroll") for (int i = 0; i < 3; ++i) { const int cid = lane + 64 * i, row = cid >> 3, ch = cid & 7, tm = tb_ - 3 + row; \
            pxr[i] = (cid < 152 && tm >= 0) ? *(const u32x4*)(xg + (rowb + tm) * D + ch * 8) : z4; } \
        _Pragma("unroll") for (int i = 0; i < 2; ++i) { const int cid = lane + 64 * i, row = cid >> 3, ch = cid & 7; \
            pgr[i] = *(const u32x4*)(gg + (rowb + tb_ + row) * D + ch * 8); } } while (0)
    RG_LOAD(0);
    LB();
    for (int tile = 0; tile < SEQ / TL; ++tile) {
        const int t0 = tile * TL;
#pragma unroll
        for (int i = 0; i < 3; ++i) { const int cid = lane + 64 * i, row = cid >> 3, ch = cid & 7; if (cid < 152) *(LAS u32x4*)(wl + W_XR + row * PITCH + ch * 16) = pxr[i]; }
#pragma unroll
        for (int i = 0; i < 2; ++i) { const int cid = lane + 64 * i, row = cid >> 3, ch = cid & 7; *(LAS u32x4*)(wl + W_GR + row * PITCH + ch * 16) = pgr[i]; }
        LDS_WAIT();
        if (tile + 1 < SEQ / TL) RG_LOAD(t0 + TL);
        bf16x8 af[2];
#pragma unroll
        for (int ks = 0; ks < 2; ++ks) { const int c0 = 32 * ks + 8 * q4;
            const LAS float* cw = (const LAS float*)(lds + L_CW);
            f32x4 s0 = *(const LAS f32x4*)(cw + 256 + c0), s1 = *(const LAS f32x4*)(cw + 256 + c0 + 4);
#pragma unroll
            for (int jj = 0; jj < 4; ++jj) { const u32x4 xv = *(const LAS u32x4*)(wl + W_XR + (l16 + jj) * PITCH + c0 * 2);
                const f32x4 w0 = *(const LAS f32x4*)(cw + jj * 64 + c0), w1 = *(const LAS f32x4*)(cw + jj * 64 + c0 + 4);
                s0 += w0 * (f32x4){bflo(xv.x), bfhi(xv.x), bflo(xv.y), bfhi(xv.y)}; s1 += w1 * (f32x4){bflo(xv.z), bfhi(xv.z), bflo(xv.w), bfhi(xv.w)}; }
            *(LAS f32x4*)(wl + W_XC + (l16 * 68 + c0) * 4) = s0; *(LAS f32x4*)(wl + W_XC + (l16 * 68 + c0 + 4) * 4) = s1;
            u32x4 w; w.x = cvtpk(s0[0], s0[1]); w.y = cvtpk(s0[2], s0[3]); w.z = cvtpk(s1[0], s1[1]); w.w = cvtpk(s1[2], s1[3]); af[ks] = __builtin_bit_cast(bf16x8, w); }
        f32x4 ra[4], rx[4];
#pragma unroll
        for (int db = 0; db < 4; ++db) { ra[db] = (f32x4){0.f, 0.f, 0.f, 0.f}; rx[db] = ra[db];
#pragma unroll
            for (int ks = 0; ks < 2; ++ks) { const bf16x8 wa = *(const LAS bf16x8*)(lds + L_WF + (((0 * 4 + db) * 2 + ks) * 64 + lane) * 16), wx = *(const LAS bf16x8*)(lds + L_WF + (((1 * 4 + db) * 2 + ks) * 64 + lane) * 16);
                ra[db] = __builtin_amdgcn_mfma_f32_16x16x32_bf16(af[ks], wa, ra[db], 0, 0, 0); rx[db] = __builtin_amdgcn_mfma_f32_16x16x32_bf16(af[ks], wx, rx[db], 0, 0, 0); } }
        LDS_WAIT();
        float av[4][4], uv[4][4], gl[4][4], EA[4], EH[4];
        const int tc = 4 * q4;
        LAS unsigned char* agg = lds + L_AGG + (tile & 1) * 4096;
#pragma unroll
        for (int db = 0; db < 4; ++db) { const int d = 16 * db + l16;
#pragma unroll
            for (int j = 0; j < 4; ++j) {
                const float xc = *(const LAS float*)(wl + W_XC + ((tc + j) * 68 + d) * 4);
                const float g = bf2f(*(const LAS unsigned short*)(wl + W_GR + (tc + j) * PITCH + d * 2));
                const float r = sigmoidf_(ra[db][j] + ba[db]), ig = sigmoidf_(rx[db][j] + bx[db]);
                const float a = fast_exp2(r * sp[db]);
                av[db][j] = a; uv[db][j] = __builtin_amdgcn_sqrtf(fmaxf(1.0f - a * a, 0.f)) * (ig * xc);
                gl[db][j] = g * fast_rcp(1.0f + fast_exp2(g * ((-2.0f * 0.7978845608028654f * LOG2E) + (-2.0f * 0.7978845608028654f * LOG2E * 0.044715f) * (g * g))));
            }
            float a_ = av[db][0] * av[db][1] * av[db][2] * av[db][3];
            float h_ = ((uv[db][0] * av[db][1] + uv[db][1]) * av[db][2] + uv[db][2]) * av[db][3] + uv[db][3];
            float pa = RG_UP(a_, sh16), ph = RG_UP(h_, sh16);
            if (q4 >= 1) { h_ = ph * a_ + h_; a_ = pa * a_; }
            pa = RG_UP(a_, sh32); ph = RG_UP(h_, sh32);
            if (q4 >= 2) { h_ = ph * a_ + h_; a_ = pa * a_; }
            EA[db] = RG_UP(a_, sh16); EH[db] = RG_UP(h_, sh16);
            if (q4 == 3) { *(LAS f32x2*)(agg + ((wid * 64 + d) * 2) * 4) = (f32x2){a_, h_}; }
        }
        LB();
#pragma unroll
        for (int db = 0; db < 4; ++db) { const int d = 16 * db + l16;
            float hw = hin[db], hall = hin[db];
#pragma unroll
            for (int w2 = 0; w2 < 8; ++w2) { const f32x2 ag = *(const LAS f32x2*)(agg + ((w2 * 64 + d) * 2) * 4); hall = ag.x * hall + ag.y; if (w2 < wid) hw = hall; }
            hin[db] = hall;
            float h = (q4 == 0) ? hw : (EA[db] * hw + EH[db]);
#pragma unroll
            for (int j = 0; j < 4; ++j) { h = av[db][j] * h + uv[db][j];
                const unsigned yb = cvtpk(h * gl[db][j], 0.f);
                *(LAS unsigned short*)(wl + W_GR + (tc + j) * PITCH + d * 2) = (unsigned short)(yb & 0xffffu); }
        }
        LDS_WAIT();
#pragma unroll
        for (int i = 0; i < 2; ++i) { const int cid = lane + 64 * i, row = cid >> 3, ch = cid & 7;
            *(u32x4*)(yg + (rowb + t0 + 16 * wid + row) * D + ch * 8) = *(const LAS u32x4*)(wl + W_GR + row * PITCH + ch * 16); }
        LDS_WAIT();
    }
#undef RG_LOAD
#undef RG_UP
    LB();
}
}

namespace att {
constexpr int STG = 32768;
constexpr int NSTG = 4;
constexpr int L_WS = LDSCTL_OFF + 1024  , L_BT = LDSCTL_OFF + 3072  , L_OS = 65536  , L_X = 0  ;
constexpr int BT_DMAX = 208, BT_STRIDE = 344, L_BT4 = LDSCTL_OFF + 4096  ;
__device__ __forceinline__ int bt4_word(int c, int u) { return c * BT_STRIDE + ((4 - c) & 3) + u; }
constexpr int OSP = 272;
constexpr float THR = 8.0f;
struct Tensors { const bf16_t* Q; const bf16_t* K; const bf16_t* V; bf16_t* Y; const float* bt; const float* subg; const float* lam; const float* km2; const float* bmax; };
__device__ __forceinline__ int crow(int r, int hi) { return (r & 3) + 8 * (r >> 2) + 4 * hi; }
typedef short v4i16_t __attribute__((ext_vector_type(4)));
#define VTR_ISSUE(dst, p, off) asm volatile("ds_read_b64_tr_b16 %0, %1 offset:%2" : "=v"(dst) : "v"(p), "i"(off))
#define VFR_ISSUE(j, vp_) do { VTR_ISSUE(vl_[j], vp_, ((j) & 3) * 4096 + ((j) >> 2) * 1024); VTR_ISSUE(vh_[j], vp_, ((j) & 3) * 4096 + ((j) >> 2) * 1024 + 512); } while (0)
#define VFR_WAITN(n, j) asm volatile("s_waitcnt lgkmcnt(" #n ")" : "+v"(vl_[j]), "+v"(vh_[j]))
#define VFR_WAIT(j) do { if ((j) <= 11) VFR_WAITN(8, j); else if ((j) == 12) VFR_WAITN(6, j); else if ((j) == 13) VFR_WAITN(4, j); else if ((j) == 14) VFR_WAITN(2, j); else VFR_WAITN(0, j); } while (0)
#define VFR_GET(j) ((bf16x8){vl_[j][0], vl_[j][1], vl_[j][2], vl_[j][3], vh_[j][0], vh_[j][1], vh_[j][2], vh_[j][3]})
__device__ __forceinline__ float max3f(float a, float b, float c) { return __builtin_fmaxf(__builtin_fmaxf(a, b), c); }
__device__ __forceinline__ float swapmax(float m) { auto rr = __builtin_amdgcn_permlane32_swap(__float_as_uint(m), __float_as_uint(m), false, false); return fmaxf(__uint_as_float(rr[0]), __uint_as_float(rr[1])); }
__device__ __forceinline__ float swapsum(float m) { auto rr = __builtin_amdgcn_permlane32_swap(__float_as_uint(m), __float_as_uint(m), false, false); return __uint_as_float(rr[0]) + __uint_as_float(rr[1]); }

#define ATT_PK(P, B) cvtpk(P[B], P[(B) + 1])
template <class QP> __device__ __forceinline__ void unit(LAS unsigned char* lds, const Tensors& P, int& item, int& rot, bool& pre, unsigned& popv, float& btp, float& kmp, float& bmp, bf16x8 (&qr)[4], const int qlo, const int qhi, QP qctr) {
    const int tid = threadIdx.x, lane = tid & 63, r32 = lane & 31, hi = lane >> 5, wid = __builtin_amdgcn_readfirstlane(tid >> 6), map = wid >> 2, qs = wid & 3;
    const int j_ = item - 128, qb = 31 - (j_ >> 6), b = (j_ & 63) >> 3, h = j_ & 7;
    LAS unsigned* lwq = (LAS unsigned*)(lds + LDSCTL_OFF) + LW_Q;
#define STGOF(t) ((((t) + rot) & 3) * STG)
    const size_t rowb = (size_t)b * SEQ; const int q0 = qb * 128, qw0 = q0 + 32 * qs, NTL = 2 * qb + 2;
    LAS float* wsf = (LAS float*)(lds + L_WS) + wid * 64;
    if (tid >= 384) { const float bv_ = pre ? btp : P.bt[h * 128 + (tid - 384)] - P.bt[h * 128 + 127]; LAS float* t4_ = (LAS float*)(lds + L_BT4); const int u_ = BT_DMAX - (tid - 384);
#pragma unroll
        for (int c = 0; c < 4; ++c) t4_[bt4_word(c, u_)] = bv_; }
    const bf16_t* ks1 = P.K + ((size_t)((b * 8 + h) * 2) * 64) * 4096 + wid * 512 + lane * 8;
    const bf16_t* ks2 = ks1 + (size_t)64 * 4096;
    const bf16_t* vsa = P.V + ((size_t)(b * 8 + h) * 64) * 8192 + wid * 512 + lane * 8;
    const bf16_t* vsb = vsa + 8 * 512;
    const int dk1 = wid * 1024, dk2 = 8192 + wid * 1024, dva = 16384 + wid * 1024, dvb = 16384 + (wid + 8) * 1024;
#define ATT_DMA(t, st) do { const size_t gk = (size_t)(t) * 4096, gv = (size_t)(t) * 8192; \
        __builtin_amdgcn_global_load_lds((const GAS unsigned*)(ks1 + gk), (LAS unsigned*)(lds + (st) + dk1), 16, 0, 0); \
        __builtin_amdgcn_global_load_lds((const GAS unsigned*)(ks2 + gk), (LAS unsigned*)(lds + (st) + dk2), 16, 0, 0); \
        __builtin_amdgcn_global_load_lds((const GAS unsigned*)(vsa + gv), (LAS unsigned*)(lds + (st) + dva), 16, 0, 0); \
        __builtin_amdgcn_global_load_lds((const GAS unsigned*)(vsb + gv), (LAS unsigned*)(lds + (st) + dvb), 16, 0, 0); } while (0)
    if (!pre) {
        ATT_DMA(0, STGOF(0));
        ATT_DMA(1, STGOF(1));
#pragma unroll
        for (int d0 = 0; d0 < 4; ++d0) qr[d0] = *(const bf16x8*)(P.Q + (rowb + qw0 + r32) * D + h * 128 + map * 64 + d0 * 16 + hi * 8);
    }
    float mref = 0.f, lsum = 0.f;
    f32x16 o[4]; const f32x16 zero16 = {0.f, 0.f, 0.f, 0.f, 0.f, 0.f, 0.f, 0.f, 0.f, 0.f, 0.f, 0.f, 0.f, 0.f, 0.f, 0.f};
#pragma unroll
    for (int r = 0; r < 16; ++r) { o[0][r] = 0.f; o[1][r] = 0.f; o[2][r] = 0.f; o[3][r] = 0.f; }
    const LAS unsigned char* kb0 = lds + map * 8192 + hi * 1024 + r32 * 16;
    const LAS unsigned char* vp0 = lds + 16384 + ((lane >> 4) & 1) * 32 + (lane & 3) * 8 + (4 * hi + ((lane & 15) >> 2)) * 64;
    f32x16 pA0, pA1, pB0, pB1; u32x4 pw0, pw1, pw2, pw3; bool resc = false;
#define KFR(kb_, i) (*(const LAS bf16x8*)((kb_) + ((i) >> 1) * 2048 + ((i) & 1) * 512))
#define ATT_DECIDE(C0, C1, t, FAST) do { const int k0_ = 64 * (t); \
        if (!(FAST) && __any(mref != 0.f)) { _Pragma("unroll") for (int r = 0; r < 16; ++r) { C0[r] -= mref; C1[r] -= mref; } } \
        if ((qw0 - (k0_ + 63)) < 113) { const int u00_ = BT_DMAX - (qw0 + r32 - k0_ - 4 * hi);         \
            const LAS float* tp_ = (const LAS float*)(lds + L_BT4) + bt4_word(u00_ & 3, u00_); \
            _Pragma("unroll") for (int g = 0; g < 4; ++g) { const f32x4 t0_ = *(const LAS f32x4*)(tp_ + 8 * g), t1_ = *(const LAS f32x4*)(tp_ + 8 * g + 32); \
                _Pragma("unroll") for (int j = 0; j < 4; ++j) { C0[4 * g + j] += t0_[j]; C1[4 * g + j] += t1_[j]; } } } \
        if (!(FAST)) { \
        float rm_ = max3f(C0[0], C0[1], C1[0]), rn_ = max3f(C0[2], C0[3], C1[1]); rm_ = max3f(rm_, C1[2], C1[3]); \
        _Pragma("unroll") for (int r = 4; r < 16; r += 4) { rm_ = max3f(rm_, C0[r], C0[r + 1]); rn_ = max3f(rn_, C0[r + 2], C0[r + 3]); rm_ = max3f(rm_, C1[r], C1[r + 1]); rn_ = max3f(rn_, C1[r + 2], C1[r + 3]); } \
        rm_ = swapmax(max3f(rm_, rn_, rn_)); \
        const bool first_ = ((t) == 0);                                    \
        resc = __any(rm_ > THR || (first_ && rm_ < -THR)); \
        if (resc) { const float dl_ = first_ ? rm_ : fmaxf(rm_, 0.f); mref += dl_; \
            _Pragma("unroll") for (int r = 0; r < 16; ++r) { C0[r] -= dl_; C1[r] -= dl_; } \
            const float f_ = first_ ? 1.0f : fast_exp2(-dl_); lsum *= f_; if (hi == 0) wsf[r32] = f_; } } } while (0)
#define ATT_RESC(FAST) do { if (!(FAST) && resc) { LDS_WAIT(); \
        _Pragma("unroll") for (int r = 0; r < 16; ++r) { const float f_ = wsf[crow(r, hi)]; o[0][r] *= f_; o[1][r] *= f_; o[2][r] *= f_; o[3][r] *= f_; } } } while (0)
#define ATT_GA(CX, KF, D0, FIRST, a0, a1, a2, a3, PWX, PSRC, PB0) do { \
        CX = __builtin_amdgcn_mfma_f32_32x32x16_bf16(KF, qr[D0], (FIRST) ? negm : CX, 0, 0, 0); \
        sacc += (a0 + a1) + (a2 + a3); PWX = ATT_PK(PSRC, PB0); } while (0)
#define ATT_STEP(C0, C1, P0, P1, t, FAST) do { \
        const LAS unsigned char* kb_ = kb0 + STGOF(t); const LAS unsigned char* vp_ = vp0 + STGOF((t) + 3); \
        bf16x8 ka_ = KFR(kb_, 0), kc_ = KFR(kb_, 1); float sacc = 0.f; s16x4 vl_[16], vh_[16]; \
        SBAR(); \
        C0 = __builtin_amdgcn_mfma_f32_32x32x16_bf16(ka_, qr[0], zero16, 0, 0, 0); ka_ = KFR(kb_, 2); sacc += (P0[0] + P0[1]) + (P0[2] + P0[3]); pw0.x = ATT_PK(P0, 0); pw0.y = ATT_PK(P0, 2); asm volatile("" : "+v"(sacc)); asm volatile("" : "+v"(pw0)); SBAR(); \
        C1 = __builtin_amdgcn_mfma_f32_32x32x16_bf16(kc_, qr[0], zero16, 0, 0, 0); kc_ = KFR(kb_, 3); sacc += (P0[4] + P0[5]) + (P0[6] + P0[7]); pw0.z = ATT_PK(P0, 4); pw0.w = ATT_PK(P0, 6); asm volatile("" : "+v"(sacc)); asm volatile("" : "+v"(pw0)); SBAR(); \
        C0 = __builtin_amdgcn_mfma_f32_32x32x16_bf16(ka_, qr[1], C0, 0, 0, 0); ka_ = KFR(kb_, 4); sacc += (P0[8] + P0[9]) + (P0[10] + P0[11]); pw1.x = ATT_PK(P0, 8); pw1.y = ATT_PK(P0, 10); asm volatile("" : "+v"(sacc)); asm volatile("" : "+v"(pw1)); SBAR(); \
        C1 = __builtin_amdgcn_mfma_f32_32x32x16_bf16(kc_, qr[1], C1, 0, 0, 0); kc_ = KFR(kb_, 5); sacc += (P0[12] + P0[13]) + (P0[14] + P0[15]); pw1.z = ATT_PK(P0, 12); pw1.w = ATT_PK(P0, 14); asm volatile("" : "+v"(sacc)); asm volatile("" : "+v"(pw1)); SBAR(); \
        C0 = __builtin_amdgcn_mfma_f32_32x32x16_bf16(ka_, qr[2], C0, 0, 0, 0); ka_ = KFR(kb_, 6); sacc += (P1[0] + P1[1]) + (P1[2] + P1[3]); pw2.x = ATT_PK(P1, 0); pw2.y = ATT_PK(P1, 2); asm volatile("" : "+v"(sacc)); asm volatile("" : "+v"(pw2)); SBAR(); \
        C1 = __builtin_amdgcn_mfma_f32_32x32x16_bf16(kc_, qr[2], C1, 0, 0, 0); kc_ = KFR(kb_, 7); sacc += (P1[4] + P1[5]) + (P1[6] + P1[7]); pw2.z = ATT_PK(P1, 4); pw2.w = ATT_PK(P1, 6); asm volatile("" : "+v"(sacc)); asm volatile("" : "+v"(pw2)); SBAR(); \
        C0 = __builtin_amdgcn_mfma_f32_32x32x16_bf16(ka_, qr[3], C0, 0, 0, 0); VFR_ISSUE(0, vp_); VFR_ISSUE(1, vp_); sacc += (P1[8] + P1[9]) + (P1[10] + P1[11]); pw3.x = ATT_PK(P1, 8); pw3.y = ATT_PK(P1, 10); asm volatile("" : "+v"(sacc)); asm volatile("" : "+v"(pw3)); SBAR(); \
        C1 = __builtin_amdgcn_mfma_f32_32x32x16_bf16(kc_, qr[3], C1, 0, 0, 0); VFR_ISSUE(2, vp_); VFR_ISSUE(3, vp_); sacc += (P1[12] + P1[13]) + (P1[14] + P1[15]); pw3.z = ATT_PK(P1, 12); pw3.w = ATT_PK(P1, 14); asm volatile("" : "+v"(sacc)); asm volatile("" : "+v"(pw3)); SBAR(); \
        lsum += sacc; \
        ATT_DECIDE(C0, C1, t, FAST); SBAR(); \
        _Pragma("unroll") for (int j = 0; j < 16; ++j) { \
            if (j + 4 < 16) VFR_ISSUE(j + 4, vp_); \
            VFR_WAIT(j); asm volatile("s_nop 1");     \
            const u32x4 pwj_ = (j >> 2) == 0 ? pw0 : (j >> 2) == 1 ? pw1 : (j >> 2) == 2 ? pw2 : pw3; \
            o[j & 3] = __builtin_amdgcn_mfma_f32_32x32x16_bf16(__builtin_bit_cast(bf16x8, pwj_), VFR_GET(j), o[j & 3], 0, 0, 0); \
            if (j < 8) { C0[2 * j] = fast_exp2(C0[2 * j]); C0[2 * j + 1] = fast_exp2(C0[2 * j + 1]); asm volatile("" : "+v"(C0)); } else { C1[2 * j - 16] = fast_exp2(C1[2 * j - 16]); C1[2 * j - 15] = fast_exp2(C1[2 * j - 15]); asm volatile("" : "+v"(C1)); } \
            SBAR(); } \
        ATT_RESC(FAST); } while (0)
#define ATT_TOP(t) do { if ((t) == 0 && pre) asm volatile("s_waitcnt vmcnt(8) lgkmcnt(0)\n\ts_barrier" ::: "memory");     \
        else if ((t) + 1 < NTL) asm volatile("s_waitcnt vmcnt(4) lgkmcnt(0)\n\ts_barrier" ::: "memory"); else WG_BAR(); \
        if ((t) == 0 && pre && tid == 448) lwq[0] = popv;                      \
        if ((t) + 2 < NTL) ATT_DMA((t) + 2, STGOF((t) + 2)); } while (0)
#define ATT_DRAIN(P0, P1, vp_) do { float sacc = 0.f; \
        _Pragma("unroll") for (int r = 0; r < 16; ++r) sacc += P0[r] + P1[r]; \
        lsum += sacc; \
        pw0 = (u32x4){ATT_PK(P0, 0), ATT_PK(P0, 2), ATT_PK(P0, 4), ATT_PK(P0, 6)}; pw1 = (u32x4){ATT_PK(P0, 8), ATT_PK(P0, 10), ATT_PK(P0, 12), ATT_PK(P0, 14)}; \
        pw2 = (u32x4){ATT_PK(P1, 0), ATT_PK(P1, 2), ATT_PK(P1, 4), ATT_PK(P1, 6)}; pw3 = (u32x4){ATT_PK(P1, 8), ATT_PK(P1, 10), ATT_PK(P1, 12), ATT_PK(P1, 14)}; \
        s16x4 vl_[16], vh_[16]; VFR_ISSUE(0, vp_); VFR_ISSUE(1, vp_); VFR_ISSUE(2, vp_); VFR_ISSUE(3, vp_); \
        _Pragma("unroll") for (int j = 0; j < 16; ++j) { if (j + 4 < 16) VFR_ISSUE(j + 4, vp_); \
            VFR_WAIT(j); \
            const u32x4 pwj_ = (j >> 2) == 0 ? pw0 : (j >> 2) == 1 ? pw1 : (j >> 2) == 2 ? pw2 : pw3; \
            o[j & 3] = __builtin_amdgcn_mfma_f32_32x32x16_bf16(__builtin_bit_cast(bf16x8, pwj_), VFR_GET(j), o[j & 3], 0, 0, 0); } } while (0)
    bool fast;
    {   float qn = 0.f;
#pragma unroll
        for (int d0 = 0; d0 < 4; ++d0) { const u32x4 w = __builtin_bit_cast(u32x4, qr[d0]); const float a0 = bflo(w.x), a1 = bfhi(w.x), a2 = bflo(w.y), a3 = bfhi(w.y), a4 = bflo(w.z), a5 = bfhi(w.z), a6 = bflo(w.w), a7 = bfhi(w.w);
            qn += (a0 * a0 + a1 * a1) + (a2 * a2 + a3 * a3) + (a4 * a4 + a5 * a5) + (a6 * a6 + a7 * a7); }
        qn = swapsum(qn);
        const float km2 = (pre ? kmp : P.km2[((b * 8 + h) * 2 + map) * 2] + P.km2[((b * 8 + h) * 2 + map) * 2 + 1]) * 1.05f;
        const float bound = sqrtf(qn * km2) + (pre ? bmp : P.bmax[h]);
        fast = !__any(!(bound < 96.0f));
    }
#define ATT_WALK(FAST) do { \
    ATT_TOP(0); \
    { const LAS unsigned char* kbf_ = kb0 + STGOF(0); _Pragma("unroll") for (int d0 = 0; d0 < 4; ++d0) { const bf16x8 k0_ = KFR(kbf_, 2 * d0), k1_ = KFR(kbf_, 2 * d0 + 1); \
            pA0 = __builtin_amdgcn_mfma_f32_32x32x16_bf16(k0_, qr[d0], d0 == 0 ? zero16 : pA0, 0, 0, 0); pA1 = __builtin_amdgcn_mfma_f32_32x32x16_bf16(k1_, qr[d0], d0 == 0 ? zero16 : pA1, 0, 0, 0); } \
        ATT_DECIDE(pA0, pA1, 0, FAST); \
        _Pragma("unroll") for (int r = 0; r < 16; ++r) { pA0[r] = fast_exp2(pA0[r]); pA1[r] = fast_exp2(pA1[r]); } \
        ATT_RESC(FAST); } \
    int t = 1; \
    _Pragma("unroll 1") for (; t + 1 < NTL; t += 2) { \
        ATT_TOP(t); ATT_STEP(pB0, pB1, pA0, pA1, t, FAST); \
        ATT_TOP(t + 1); ATT_STEP(pA0, pA1, pB0, pB1, t + 1, FAST); } \
    ATT_TOP(t); ATT_STEP(pB0, pB1, pA0, pA1, t, FAST); \
    { const LAS unsigned char* vpl = vp0 + STGOF(NTL - 1); ATT_DRAIN(pB0, pB1, vpl); } } while (0)
    if (fast) ATT_WALK(1);
    else {
#pragma unroll 1
        for (int t = 0; t < NTL; ++t) {
            ATT_TOP(t);
            const LAS unsigned char* kb_ = kb0 + STGOF(t); const LAS unsigned char* vp_ = vp0 + STGOF(t);
#pragma unroll
            for (int d0 = 0; d0 < 4; ++d0) { const bf16x8 k0_ = KFR(kb_, 2 * d0), k1_ = KFR(kb_, 2 * d0 + 1);
                pA0 = __builtin_amdgcn_mfma_f32_32x32x16_bf16(k0_, qr[d0], d0 == 0 ? zero16 : pA0, 0, 0, 0); pA1 = __builtin_amdgcn_mfma_f32_32x32x16_bf16(k1_, qr[d0], d0 == 0 ? zero16 : pA1, 0, 0, 0); }
            ATT_DECIDE(pA0, pA1, t, 0);
            ATT_RESC(0);
            float sacc = 0.f;
#pragma unroll
            for (int r = 0; r < 16; ++r) { pA0[r] = fast_exp2(pA0[r]); pA1[r] = fast_exp2(pA1[r]); sacc += pA0[r] + pA1[r]; }
            lsum += sacc;
            pw0 = (u32x4){ATT_PK(pA0, 0), ATT_PK(pA0, 2), ATT_PK(pA0, 4), ATT_PK(pA0, 6)}; pw1 = (u32x4){ATT_PK(pA0, 8), ATT_PK(pA0, 10), ATT_PK(pA0, 12), ATT_PK(pA0, 14)};
            pw2 = (u32x4){ATT_PK(pA1, 0), ATT_PK(pA1, 2), ATT_PK(pA1, 4), ATT_PK(pA1, 6)}; pw3 = (u32x4){ATT_PK(pA1, 8), ATT_PK(pA1, 10), ATT_PK(pA1, 12), ATT_PK(pA1, 14)};
            s16x4 vl_[16], vh_[16];
#pragma unroll
            for (int j = 0; j < 16; ++j) { if (j == 0) { VFR_ISSUE(0, vp_); VFR_ISSUE(1, vp_); VFR_ISSUE(2, vp_); VFR_ISSUE(3, vp_); }
                if (j + 4 < 16) VFR_ISSUE(j + 4, vp_);
                VFR_WAIT(j);
                const u32x4 pwj_ = (j >> 2) == 0 ? pw0 : (j >> 2) == 1 ? pw1 : (j >> 2) == 2 ? pw2 : pw3;
                o[j & 3] = __builtin_amdgcn_mfma_f32_32x32x16_bf16(__builtin_bit_cast(bf16x8, pwj_), VFR_GET(j), o[j & 3], 0, 0, 0); }
        }
    }
#undef ATT_WALK
#undef ATT_TOP
#undef ATT_DMA
#undef ATT_DRAIN
#undef ATT_STEP
#undef ATT_GA
#undef ATT_DECIDE
#undef ATT_RESC
#undef KFR
#undef VFR_ISSUE
#undef VFR_WAIT
#undef VFR_WAITN
#undef VFR_GET
#undef VTR_ISSUE
    int lane_e = lane; asm volatile("" : "+v"(lane_e));
    const int r32e = lane_e & 31, hie = lane_e >> 5;
    LAS float* wsfe = (LAS float*)(lds + L_WS) + wid * 64;
    float lam = 0.f, sg_[4] = {0.f, 0.f, 0.f, 0.f};
    if (map == 0) { lam = P.lam[0];
#pragma unroll
        for (int db = 0; db < 4; ++db) sg_[db] = P.subg[db * 32 + r32e]; }
    lsum = swapsum(lsum);
    if (hie == 0) wsfe[32 + r32e] = lsum;
    LDS_WAIT();
#pragma unroll
    for (int r = 0; r < 16; ++r) { const float rl = fast_rcp(wsfe[32 + crow(r, hie)]);
#pragma unroll
        for (int db = 0; db < 4; ++db) o[db][r] *= rl; }
    WG_BAR();
    asm volatile("" : "+v"(sg_[0]), "+v"(sg_[1]), "+v"(sg_[2]), "+v"(sg_[3]), "+v"(lam));
    const int nxt = __builtin_amdgcn_readfirstlane((int)lwq[0]) + qlo, rotn = (NTL + rot) & 3;
    const int jn = nxt - 128, qbn = 31 - (jn >> 6), bn = (jn & 63) >> 3, hn = jn & 7;
    if (nxt < qhi) {
        const int widn = lane_e >> 6 ? 0 : wid;
        const bf16_t* k1n = P.K + ((size_t)((bn * 8 + hn) * 2) * 64) * 4096 + widn * 512 + lane_e * 8; const bf16_t* k2n = k1n + (size_t)64 * 4096;
        const bf16_t* van = P.V + ((size_t)(bn * 8 + hn) * 64) * 8192 + widn * 512 + lane_e * 8; const bf16_t* vbn = van + 8 * 512;
#pragma unroll
        for (int tn = 0; tn < 2; ++tn) { const int stn = ((tn + rotn) & 3) * STG;
            __builtin_amdgcn_global_load_lds((const GAS unsigned*)(k1n + (size_t)tn * 4096), (LAS unsigned*)(lds + stn + dk1), 16, 0, 0);
            __builtin_amdgcn_global_load_lds((const GAS unsigned*)(k2n + (size_t)tn * 4096), (LAS unsigned*)(lds + stn + dk2), 16, 0, 0);
            __builtin_amdgcn_global_load_lds((const GAS unsigned*)(van + (size_t)tn * 8192), (LAS unsigned*)(lds + stn + dva), 16, 0, 0);
            __builtin_amdgcn_global_load_lds((const GAS unsigned*)(vbn + (size_t)tn * 8192), (LAS unsigned*)(lds + stn + dvb), 16, 0, 0); }
#pragma unroll
        for (int d0 = 0; d0 < 4; ++d0) qr[d0] = *(const bf16x8*)(P.Q + ((size_t)bn * SEQ + qbn * 128 + 32 * qs + r32e) * D + hn * 128 + map * 64 + d0 * 16 + hie * 8);
        kmp = P.km2[((bn * 8 + hn) * 2 + map) * 2] + P.km2[((bn * 8 + hn) * 2 + map) * 2 + 1]; bmp = P.bmax[hn];
    }
    const int xb = STGOF(NTL - 2);
    LAS float* xq = (LAS float*)(lds + xb) + qs * 4096;
    if (map == 1) {
#pragma unroll
        for (int db = 0; db < 4; ++db)
#pragma unroll
            for (int r = 0; r < 16; ++r) xq[crow(r, hie) * 128 + db * 32 + r32e] = o[db][r];
    }
    LB();
    if (map == 1) {
        if (nxt < qhi) { if (tid >= 384) btp = P.bt[hn * 128 + (tid - 384)] - P.bt[hn * 128 + 127];
            if (tid == 448) popv = __hip_atomic_fetch_add(qctr, 1u, __ATOMIC_RELAXED, __HIP_MEMORY_SCOPE_AGENT); } }
    if (map == 0) {
        float ss[16];
#pragma unroll
        for (int r = 0; r < 16; ++r) { float s = 0.f;
#pragma unroll
            for (int db = 0; db < 4; ++db) { const float v = o[db][r] - lam * xq[crow(r, hie) * 128 + db * 32 + r32e]; o[db][r] = v; s += v * v; }
            ss[r] = s; }
#pragma unroll
        for (int r = 0; r < 16; ++r) { float s = ss[r];
#pragma unroll
            for (int of = 1; of < 32; of <<= 1) s += __shfl_xor(s, of);
            ss[r] = (1.0f - LAM_INIT) / sqrtf(s * (1.0f / 128.0f) + EPS); }
        LAS unsigned char* os = lds + xb + qs * 16384;
#pragma unroll
        for (int db = 0; db < 4; ++db) { const float g = sg_[db];
#pragma unroll
            for (int r = 0; r < 16; ++r) { const unsigned yb = cvtpk(o[db][r] * ss[r] * g, 0.f); *(LAS unsigned short*)(os + crow(r, hie) * OSP + (db * 32 + r32e) * 2) = (unsigned short)(yb & 0xffffu); } }
    }
    LB();
    asm volatile("" : "+v"(qr[0]), "+v"(qr[1]), "+v"(qr[2]), "+v"(qr[3]), "+v"(kmp), "+v"(bmp));
    if (map == 1) {
        const LAS unsigned char* os = lds + xb + qs * 16384;
        bf16_t* yg = P.Y + (rowb + qw0) * D + h * 128;
#pragma unroll
        for (int i = 0; i < 8; ++i) { const int cid = i * 64 + lane_e, row = cid >> 4, ch = cid & 15; *(u32x4*)(yg + (size_t)row * D + ch * 8) = *(const LAS u32x4*)(os + row * OSP + ch * 16); }
    }
    item = nxt; rot = rotn; pre = true;
#undef STGOF
}
#undef ATT_PK
}

namespace router {
constexpr int L_LG = 0  , L_HIST = 32768  , L_BASE = 32768 + 128  ;
struct Tensors { const float* x; const bf16_t* delta; const float* g; const bf16_t* rfrag; const float* brouter; bf16_t* hf; unsigned* list; float* rs; float* wt; unsigned* cnt; bf16_t* x1; };
__device__ __forceinline__ void block(LAS unsigned char* lds, const Tensors& P, int tb) {
    const int tid = threadIdx.x, lane = tid & 63, wid = __builtin_amdgcn_readfirstlane(tid >> 6), l16 = lane & 15, q4 = lane >> 4;
    LAS unsigned* hist = (LAS unsigned*)(lds + L_HIST); LAS unsigned* basew = (LAS unsigned*)(lds + L_BASE);
    if (tid < 32) hist[tid] = 0u;
    const int tok = tb * 128 + wid * 16 + l16;
    const float* __restrict__ xrow = P.x + (size_t)tok * D + 8 * q4; const bf16_t* __restrict__ drow = P.delta + (size_t)tok * D + 8 * q4; unsigned char* __restrict__ hrow = (unsigned char*)P.hf + (size_t)tok * D + 8 * q4;
    bf16_t* __restrict__ x1row = P.x1 + (size_t)tok * D + 8 * q4;
    f32x4 acc0 = {0.f, 0.f, 0.f, 0.f}, acc1 = acc0; float ss = 0.f;
#pragma unroll 32
    for (int ks = 0; ks < 32; ++ks) {
        const f32x4 xa = *(const f32x4*)(xrow + ks * 32), xb = *(const f32x4*)(xrow + ks * 32 + 4);
        const u32x4 dv = *(const u32x4*)(drow + ks * 32);
        const f32x4 ga = *(const f32x4*)(P.g + ks * 32 + 8 * q4), gb = *(const f32x4*)(P.g + ks * 32 + 8 * q4 + 4);
        f32x4 da, db; epi::unpack8(dv, da, db);
        const f32x4 ya = xa + da, yb = xb + db;
        *(u32x4*)(x1row + ks * 32) = epi::pack8(ya, yb);
        ss += (ya[0] * ya[0] + ya[1] * ya[1]) + (ya[2] * ya[2] + ya[3] * ya[3]) + (yb[0] * yb[0] + yb[1] * yb[1]) + (yb[2] * yb[2] + yb[3] * yb[3]);
        const f32x4 va = ya * ga, vb = yb * gb;
        const u32x4 hw = epi::pack8(va, vb);
        { u32x2 h8; h8.x = cvt4_fp8(va[0], va[1], va[2], va[3]); h8.y = cvt4_fp8(vb[0], vb[1], vb[2], vb[3]); *(u32x2*)(hrow + ks * 32) = h8; }
        f32x4 ha, hb; epi::unpack8(hw, ha, hb);
        const u32x4 lw = epi::pack8(va - ha, vb - hb);
        const bf16x8 bh = __builtin_bit_cast(bf16x8, hw), bl = __builtin_bit_cast(bf16x8, lw);
        const bf16x8* fr = (const bf16x8*)P.rfrag + (size_t)ks * 256 + lane;
        const bf16x8 ah0 = fr[0], al0 = fr[64], ah1 = fr[128], al1 = fr[192];
        acc0 = __builtin_amdgcn_mfma_f32_16x16x32_bf16(ah0, bh, acc0, 0, 0, 0); acc0 = __builtin_amdgcn_mfma_f32_16x16x32_bf16(al0, bh, acc0, 0, 0, 0); acc0 = __builtin_amdgcn_mfma_f32_16x16x32_bf16(ah0, bl, acc0, 0, 0, 0);
        acc1 = __builtin_amdgcn_mfma_f32_16x16x32_bf16(ah1, bh, acc1, 0, 0, 0); acc1 = __builtin_amdgcn_mfma_f32_16x16x32_bf16(al1, bh, acc1, 0, 0, 0); acc1 = __builtin_amdgcn_mfma_f32_16x16x32_bf16(ah1, bl, acc1, 0, 0, 0);
    }
    ss += __shfl_xor(ss, 16); ss += __shfl_xor(ss, 32);
    const float rstd = 1.0f / sqrtf(ss * (1.0f / D) + EPS);
    LAS float* lg = (LAS float*)(lds + L_LG) + (wid * 16 + l16) * 33;
#pragma unroll
    for (int j = 0; j < 4; ++j) { lg[4 * q4 + j] = acc0[j] * rstd + P.brouter[4 * q4 + j]; lg[16 + 4 * q4 + j] = acc1[j] * rstd + P.brouter[16 + 4 * q4 + j]; }
    LB();
    int se[4] = {0, 0, 0, 0}; float sw[4] = {0.f, 0.f, 0.f, 0.f}; unsigned rk[4] = {0u, 0u, 0u, 0u};
    if (q4 == 0) {
        float v[32];
#pragma unroll
        for (int e = 0; e < 32; ++e) v[e] = lg[e];
        float tv[4];
#pragma unroll
        for (int k = 0; k < 4; ++k) { float best = -INFINITY; int bi = 0;
#pragma unroll
            for (int e = 0; e < 32; ++e) { const bool tk = v[e] > best; best = tk ? v[e] : best; bi = tk ? e : bi; }
            tv[k] = best; se[k] = bi;
#pragma unroll
            for (int e = 0; e < 32; ++e) v[e] = (e == bi) ? -INFINITY : v[e]; }
        float den = 0.f;
#pragma unroll
        for (int k = 0; k < 4; ++k) { sw[k] = fast_exp2((tv[k] - tv[0]) * LOG2E); den += sw[k]; }
        const float rd = 1.0f / den;
#pragma unroll
        for (int k = 0; k < 4; ++k) { sw[k] *= rd; rk[k] = __hip_atomic_fetch_add(hist + se[k], 1u, __ATOMIC_RELAXED, __HIP_MEMORY_SCOPE_WORKGROUP); }
    }
    LB();
    if (tid < 32) basew[tid] = __hip_atomic_fetch_add(P.cnt + tid, hist[tid], RLX_AGENT);
    LB();
    if (q4 == 0) {
#pragma unroll
        for (int k = 0; k < 4; ++k) { const size_t pos = (size_t)se[k] * T + basew[se[k]] + rk[k];
            P.list[pos] = (unsigned)tok * 4u + (unsigned)k; P.rs[pos] = rstd; P.wt[pos] = sw[k]; }
    }
    LB();
}
}

__device__ __forceinline__ void final_row(const float* xrow, const bf16_t* drow, const bf16_t* yrows, float* orow, const f32x4 (&g)[4], int lane) {
    f32x4 v[4]; float s = 0.f;
#pragma unroll
    for (int j = 0; j < 4; ++j) { const u32x2 dw = *((const u32x2*)drow + lane + 64 * j); v[j] = (f32x4){bflo(dw.x), bfhi(dw.x), bflo(dw.y), bfhi(dw.y)};
#pragma unroll
        for (int k = 0; k < 4; ++k) { const u32x2 yw = *((const u32x2*)(yrows + (size_t)k * D) + lane + 64 * j); v[j] += (f32x4){bflo(yw.x), bfhi(yw.x), bflo(yw.y), bfhi(yw.y)}; }
        s += (v[j].x * v[j].x + v[j].y * v[j].y) + (v[j].z * v[j].z + v[j].w * v[j].w); }
    const float rstd = 1.0f / sqrtf(wave_sum(s) * (1.f / D) + EPS);
#pragma unroll
    for (int j = 0; j < 4; ++j) *((f32x4*)orow + lane + 64 * j) = v[j] * rstd * g[j];
}

constexpr int NPH = 10;
constexpr int N_LAUNCHES = MK_N_LAUNCHES;
__global__ void __launch_bounds__(NTHREADS, 2) hybrid_fwd(Args args) {
    extern __shared__ __attribute__((aligned(16))) unsigned char lds_raw[];
    LAS unsigned char* lds = (LAS unsigned char*)lds_raw;
    LAS unsigned* LW = (LAS unsigned*)(lds + LDSCTL_OFF);
    const int tid = threadIdx.x, lane = tid & 63, wave = __builtin_amdgcn_readfirstlane(tid >> 6);
    const int G = gridDim.x, bx = blockIdx.x;
    unsigned char* ws = args.ws;
    gu32* ctl = (gu32*)(ws + WS_CTL);
    for (int u = tid; u < (LDS_BYTES - LDSCTL_OFF) / 4; u += NTHREADS) LW[u] = 0u;
    __syncthreads();
    XcdBarrier bar; bar.bar = (unsigned*)ctl + CW_BAR; bar.x = 0; bar.st = nullptr;
    if (N_LAUNCHES != NPH) bar = xcd_barrier_post((unsigned*)ctl + CW_BAR + args.li * XCD_BAR_WORDS, (volatile LAS unsigned*)(LW + LW_BAR));
    const int lo = args.ph_lo, hi = args.ph_hi;
#ifndef PH_MASK
#define PH_MASK 0x3ff
#endif
#define IN(k) ((((PH_MASK) >> (k)) & 1) && lo <= (k) && (k) < hi)
#define SEAM(k) do { if (IN(k) && IN((k) + 1)) xcd_barrier(bar); } while (0)
    bf16_t* WinT = (bf16_t*)(ws + WS_WIN_T); bf16_t* WrnnT = (bf16_t*)(ws + WS_WRNN_T); bf16_t* WattT = (bf16_t*)(ws + WS_WATT_T); bf16_t* WoutT = (bf16_t*)(ws + WS_WOUT_T);
    unsigned* LIST = (unsigned*)(ws + WS_LIST); float* RS = (float*)(ws + WS_RS); float* WT = (float*)(ws + WS_WT);
    bf16_t* U1 = (bf16_t*)(ws + WS_U(1)); bf16_t* U2 = (bf16_t*)(ws + WS_U(2)); bf16_t* U3 = (bf16_t*)(ws + WS_U(3)); bf16_t* U4 = (bf16_t*)(ws + WS_U(4));
    bf16_t* U5 = (bf16_t*)(ws + WS_U(5)); bf16_t* U6 = (bf16_t*)(ws + WS_U(6)); bf16_t* U7 = (bf16_t*)(ws + WS_U(7)); bf16_t* U8 = (bf16_t*)(ws + WS_U(8));
    bf16_t* D0 = (bf16_t*)args.out; bf16_t* D1 = D0 + (size_t)T * D;
    unsigned char* misc = ws + WS_MISC;
    bf16_t* RFRAG = (bf16_t*)(misc + MS_RFRAG); float* BT = (float*)(misc + MS_BT); float* SP = (float*)(misc + MS_SP); float* LAM = (float*)(misc + MS_LAM);
    const int gw = bx * NWAVES + wave, NGW = G * NWAVES;

    if (IN(0)) {
        LAS float* scr = (LAS float*)(lds + wave * 16384);
        constexpr int I_IN = (D / 64) * (DIN / 32), I_SQ = (D / 64) * (D / 32);
        unsigned char* Win8 = (unsigned char*)ws + WS_WIN8;
        for (int it = gw; it < I_IN + 3 * I_SQ; it += NGW) {
            int r = it;
            if (r < I_IN) { const int reg_ = ((r % (DIN / 32)) * 32) >> 10;
                            if (!((F8MASK >> reg_) & 1)) p0_transpose_item(args.in[I_WIN], D, DIN, WinT, 0, scr, r, lane);
                            else p0_transpose_item_fp8(args.in[I_WIN], D, DIN, Win8, (__builtin_popcount(F8MASK & ((1 << reg_) - 1)) - reg_) * 1024, scr, r, lane, 32.0f);
                            continue; } r -= I_IN;
            if (r < I_SQ) { p0_transpose_item(args.in[I_WPRNN], D, D, WrnnT, 0, scr, r, lane); continue; } r -= I_SQ;
            if (r < I_SQ) { p0_transpose_item(args.in[I_WPATT], D, D, WattT, 0, scr, r, lane); continue; } r -= I_SQ;
            p0_transpose_item(args.in[I_WOUT], D, D, WoutT, 0, scr, r, lane);
        }
        { f32x4 g[4];
#pragma unroll
          for (int j = 0; j < 4; ++j) g[j] = *((const f32x4*)args.in[I_NMG] + lane + 64 * j);
          for (int m = gw; m < T; m += NGW) rms_row_to_bf16(args.in[I_X] + (size_t)m * D, U1 + (size_t)m * D, (unsigned char*)U8 + (size_t)m * D, g, lane); }
        const int gt = bx * NTHREADS + tid, NGT = G * NTHREADS;
        for (int i = gt; i < 32 * 2 * 64; i += NGT) {
            const int ln = i & 63, half = (i >> 6) & 1, ks = i >> 7; float v[8], l[8]; u32x4 wh, wl;
#pragma unroll
            for (int j = 0; j < 8; ++j) v[j] = args.in[I_WROUTER][(size_t)(ks * 32 + 8 * (ln >> 4) + j) * NEXP + half * 16 + (ln & 15)];
            wh = (u32x4){cvtpk(v[0], v[1]), cvtpk(v[2], v[3]), cvtpk(v[4], v[5]), cvtpk(v[6], v[7])};
            l[0] = v[0] - bflo(wh.x); l[1] = v[1] - bfhi(wh.x); l[2] = v[2] - bflo(wh.y); l[3] = v[3] - bfhi(wh.y); l[4] = v[4] - bflo(wh.z); l[5] = v[5] - bfhi(wh.z); l[6] = v[6] - bflo(wh.w); l[7] = v[7] - bfhi(wh.w);
            wl = (u32x4){cvtpk(l[0], l[1]), cvtpk(l[2], l[3]), cvtpk(l[4], l[5]), cvtpk(l[6], l[7])};
            u32x4* dst = (u32x4*)RFRAG + (size_t)ks * 256 + half * 128 + ln; dst[0] = wh; dst[64] = wl;
        }
        for (int i = gt; i < NH * 128; i += NGT) { const int h = i >> 7, n = i & 127; BT[i] = args.in[I_REL][rel_bucket_dev(n) * NH + h] * LOG2E; }
        for (int i = gt; i < D; i += NGT) SP[i] = log1pf(expf(-args.in[I_LAMBDA][i]));
        if (gt < NH) { float mx = 0.f; for (int bk = 0; bk < 32; ++bk) mx = fmaxf(mx, fabsf(args.in[I_REL][bk * NH + gt] - args.in[I_REL][31 * NH + gt])); ((float*)(misc + MS_BMAX))[gt] = mx * LOG2E; }
        if (gt == 0) { float s1 = 0.f, s2 = 0.f; for (int i = 0; i < 64; ++i) { s1 += args.in[I_DLQ1][i] * args.in[I_DLK1][i]; s2 += args.in[I_DLQ2][i] * args.in[I_DLK2][i]; } LAM[0] = expf(s1) - expf(s2) + LAM_INIT; }
    }
    SEAM(0);
    if (IN(1)) {
        {   pg8::DenseSched S; S.O.init(T, (7 - NF8) * 1024, G, bx); S.A = (const char*)U1; S.Bt = (const char*)WinT; S.rmask = ~(unsigned)F8MASK & 0x7fu;
            epi::EpiProj E; E.out[0] = U2; E.out[1] = U3; E.out[2] = U4; E.out[3] = U5; E.out[4] = U6; E.out[5] = D0; E.out[6] = D1; E.dbg = args.dbg; E.km2 = (unsigned*)ctl + CW_KM2;
            pg8::gemm_phase(lds, S, E); }
        {   pg8::DenseSched8 S; S.O.init(T, NF8 * 1024, G, bx); S.A = (const char*)U8; S.Bt = (const char*)ws + WS_WIN8; S.rmask = (unsigned)F8MASK & 0x7fu;
            epi::EpiProjT<true> E; E.out[0] = U2; E.out[1] = U3; E.out[2] = U4; E.out[3] = U5; E.out[4] = U6; E.out[5] = D0; E.out[6] = D1; E.dbg = args.dbg; E.km2 = (unsigned*)ctl + CW_KM2;
            pg8::gemm_phase<epi::EpiProjT<true>, pg8::DenseSched8, true>(lds, S, E); }
    }
    SEAM(1);
    if (IN(2)) {
        rglru::Tensors RT{U2, U3, U1, args.in[I_CONVW], args.in[I_CONVB], args.in[I_WRGA], args.in[I_BRGA], args.in[I_WRGX], args.in[I_BRGX], SP};
        att::Tensors AT{U4, U5, U6, U4, BT, args.in[I_SUBG], LAM, (const float*)((const unsigned*)ctl + CW_KM2), (const float*)(misc + MS_BMAX)};
#define POP_ITEM(dst) do { if (tid == 0) LW[LW_Q] = __hip_atomic_fetch_add(ctl + CW_QUEUE, 1u, RLX_AGENT); WG_BAR(); dst = (int)LW[LW_Q]; WG_BAR(); } while (0)
#ifndef PROBE2_MODE
#define PROBE2_MODE 0
#endif
#ifndef PROBE_DBG
#define PROBE_DBG 0
#endif
        const int qlo = (args.li == 1 && PROBE2_MODE == 2) ? 128 : 0, qhi = (args.li == 1 && PROBE2_MODE == 1) ? 128 : 128 + 2048;
        int item; POP_ITEM(item); item += qlo;
#pragma unroll 1
        while (item < 128) { rglru::unit(lds, RT, item >> 4, item & 15); POP_ITEM(item); item += qlo; }
        if (item < qhi) {
            {   LAS float* t4 = (LAS float*)(lds + att::L_BT4);
                for (int i = tid; i < 4 * att::BT_STRIDE; i += NTHREADS) { const int c = i / att::BT_STRIDE, u = i % att::BT_STRIDE - ((4 - c) & 3); t4[i] = (u > att::BT_DMAX) ? -INFINITY : 0.f; } }
            { int n2; POP_ITEM(n2); (void)n2; }
            int rot = 0; bool pre = false; unsigned popv = 0u; float btp = 0.f, kmp = 0.f, bmp = 0.f; bf16x8 qr[4];
#pragma unroll
            for (int d0 = 0; d0 < 4; ++d0) qr[d0] = (bf16x8){0, 0, 0, 0, 0, 0, 0, 0};
#pragma unroll 1
            while (item < qhi) att::unit(lds, AT, item, rot, pre, popv, btp, kmp, bmp, qr, qlo, qhi, ctl + CW_QUEUE);
        }
#undef POP_ITEM
    }
    SEAM(2);
    if (IN(3)) {
        LAS float* scr = (LAS float*)(lds + wave * 16384);
        constexpr int I_SQ = (D / 64) * (D / 32);
        const bool copy_first = ((bx >> 3) & 1) != 0;
#define WCOPY_ALL() do { _Pragma("unroll 1") for (int it = gw; it < 3 * NEXP * I_SQ; it += NGW) { const int mat = it / (NEXP * I_SQ), r = it % (NEXP * I_SQ), e = r / I_SQ, ii = r % I_SQ; \
            const float* W = args.in[mat == 0 ? I_WGATE : (mat == 1 ? I_WUP : I_WDOWN)] + (size_t)e * D * D; unsigned char* WTp = (unsigned char*)(mat == 0 ? U3 : (mat == 1 ? U5 : U6)); \
            p0_transpose_item_fp8(W, D, D, WTp, e * D, scr, ii, lane, 32.0f); } } while (0)
        if (copy_first) WCOPY_ALL();
        __syncthreads();
        { pg8::DualSched S; S.O.init(T, D, G, bx); S.A0 = (const char*)U1; S.Bt0 = (const char*)WrnnT; S.A1 = (const char*)U4; S.Bt1 = (const char*)WattT;
          epi::EpiMerge E{U8, U2, D0, D1};
          pg8::gemm_phase(lds, S, E); }
        __syncthreads();
        if (!copy_first) WCOPY_ALL();
#undef WCOPY_ALL
    }
    SEAM(3);
    if (IN(4)) { }
    if (IN(5)) {
        pg8::DenseSched S; S.O.init(T, D, G, bx); S.A = (const char*)U2; S.Bt = (const char*)WoutT;
        epi::EpiGate<false, false> E{U7, nullptr, nullptr};
        pg8::gemm_phase(lds, S, E);
    }
    SEAM(5);
    if (IN(6)) {
        router::Tensors RT{args.in[I_X], U7, args.in[I_NFG], RFRAG, args.in[I_BROUTER], U1, LIST, RS, WT, (unsigned*)ctl + CW_CNT, U8};
        for (int tb = bx; tb < T / 128; tb += G) router::block(lds, RT, tb);
    }
    SEAM(6);
    if (IN(7) || IN(8)) {
        { int t2 = tid; asm volatile("" : "+v"(t2));
          if (t2 < 32) LW[LW_CNT + t2] = __hip_atomic_load(ctl + CW_CNT + t2, RLX_AGENT); }
        __syncthreads();
        if (tid == 0) { unsigned acc = 0u; for (int e = 0; e < 32; ++e) { LW[LW_TS + e] = acc; acc += (LW[LW_CNT + e] + 255u) >> 8; } LW[LW_TS + 32] = acc; }
        __syncthreads();
    }
    unsigned char* actb[2] = {(unsigned char*)D0, ws + WS_S};
    if (IN(7)) {
        epi::MoeSched<8, true> S; S.G = G; S.c = bx; S.ntl = __builtin_amdgcn_readfirstlane((int)LW[LW_TS + 32]); S.ts = (const LAS int*)(LW + LW_TS); S.cn = (const LAS int*)(LW + LW_CNT);
        S.A = (const char*)U1; S.list = LIST; S.W0 = (const char*)U3; S.W1 = (const char*)U5;
        S.actbase[0] = actb[0]; S.actbase[1] = actb[1];
        epi::EpiGU E; E.bg = args.in[I_BGATE]; E.bu = args.in[I_BUP]; E.rs = RS; E.actbase[0] = actb[0]; E.actbase[1] = actb[1];
        pg8::gemm_phase<epi::EpiGU, epi::MoeSched<8, true>, true>(lds, S, E);
    }
    SEAM(7);
    if (IN(8)) {
        epi::MoeSched<4, false> S; S.G = G; S.c = bx; S.ntl = __builtin_amdgcn_readfirstlane((int)LW[LW_TS + 32]); S.ts = (const LAS int*)(LW + LW_TS); S.cn = (const LAS int*)(LW + LW_CNT);
        S.A = nullptr; S.list = LIST; S.W0 = (const char*)U6; S.W1 = nullptr;
        S.actbase[0] = actb[0]; S.actbase[1] = actb[1];
        epi::EpiDown E; E.bd = args.in[I_BDOWN]; E.wt = WT; E.list = LIST; E.ybase = (unsigned char*)U1; E.junk = misc + 512 * 1024;
        pg8::gemm_phase<epi::EpiDown, epi::MoeSched<4, false>, true>(lds, S, E);
    }
    SEAM(8);
    if (IN(9)) {
        f32x4 g[4];
#pragma unroll
        for (int j = 0; j < 4; ++j) g[j] = *((const f32x4*)args.in[I_NFINAL] + lane + 64 * j);
        for (int m = gw; m < T; m += NGW) { const bf16_t* yb = U1 + (size_t)m * 4 * D;
            final_row(args.in[I_X] + (size_t)m * D, U8 + (size_t)m * D, yb, args.out + (size_t)m * D, g, lane); }
    }
#undef IN
#undef SEAM
}

extern "C" void kernel_launch(void* const* d_in, const int* in_sizes, int n_in, void* d_out, int out_size, void* d_ws, size_t ws_size, hipStream_t stream) {
    static int grid = 0;
    if (grid == 0) {
        if (n_in != 29 || in_sizes[0] != T * D || out_size != T * D || ws_size < WS_END) { fprintf(stderr, "kernel_launch: unexpected shapes / workspace (n_in %d, ws %zu < %zu)\n", n_in, ws_size, (size_t)WS_END); grid = -1; return; }
        int dev = 0, cus = 0;
        if (hipGetDevice(&dev) != hipSuccess || hipDeviceGetAttribute(&cus, hipDeviceAttributeMultiprocessorCount, dev) != hipSuccess) { grid = -1; return; }
        if (hipFuncSetAttribute((const void*)hybrid_fwd, hipFuncAttributeMaxDynamicSharedMemorySize, LDS_BYTES) != hipSuccess) { fprintf(stderr, "kernel_launch: hipFuncSetAttribute failed\n"); grid = -1; return; }
        int per_cu = 0;
        if (hipOccupancyMaxActiveBlocksPerMultiprocessor(&per_cu, (const void*)hybrid_fwd, NTHREADS, LDS_BYTES) != hipSuccess || per_cu < 1) fprintf(stderr, "kernel_launch: occupancy query reports %d\n", per_cu);
        (void)hipGetLastError();
        grid = cus;
    }
    if (grid < 0) return;
    (void)hipMemsetAsync((char*)d_ws + WS_CTL, 0, CTL_ZERO_BYTES, stream);
    Args a{};
    for (int i = 0; i < 29; ++i) a.in[i] = (const float*)d_in[i];
    a.out = (float*)d_out; a.ws = (unsigned char*)d_ws;
#if defined(PROBE_PHASE)
    { const int k = PROBE_PHASE;
      if (k == 2) {
        a.ph_lo = 0; a.ph_hi = NPH; a.li = 0; hipLaunchKernelGGL(hybrid_fwd, dim3(grid), dim3(NTHREADS), LDS_BYTES, stream, a);
        (void)hipMemsetAsync((char*)d_ws + WS_CTL + CW_QUEUE * 4, 0, 4, stream);
        a.ph_lo = 2; a.ph_hi = 3; a.li = 1; hipLaunchKernelGGL(hybrid_fwd, dim3(grid), dim3(NTHREADS), LDS_BYTES, stream, a);
      } else {
        a.ph_lo = 0; a.ph_hi = k + 1; a.li = 0; hipLaunchKernelGGL(hybrid_fwd, dim3(grid), dim3(NTHREADS), LDS_BYTES, stream, a);
        if (k == 6) (void)hipMemsetAsync((char*)d_ws + WS_CTL + CW_CNT * 4, 0, 32 * 4, stream);
        a.ph_lo = k; a.ph_hi = k + 1; a.li = 1; a.dbg = PROBE_DBG; hipLaunchKernelGGL(hybrid_fwd, dim3(grid), dim3(NTHREADS), LDS_BYTES, stream, a);
        a.dbg = 0;
        if (k + 1 < NPH) { a.ph_lo = k + 1; a.ph_hi = NPH; a.li = 2; hipLaunchKernelGGL(hybrid_fwd, dim3(grid), dim3(NTHREADS), LDS_BYTES, stream, a); }
      } }
#else
    if (N_LAUNCHES == 1) { a.ph_lo = 0; a.ph_hi = NPH; a.li = 0; hipLaunchKernelGGL(hybrid_fwd, dim3(grid), dim3(NTHREADS), LDS_BYTES, stream, a); }
    else for (int p = 0; p < NPH; ++p) { a.ph_lo = p; a.ph_hi = p + 1; a.li = 0; hipLaunchKernelGGL(hybrid_fwd, dim3(grid), dim3(NTHREADS), LDS_BYTES, stream, a); }
#endif
}
```
